# Optimizing an MI355X kernel written in HIP

```python
import jax, jax.numpy as jnp
from jax import lax
import numpy as np

D_MODEL = 2048
BATCH = 4
SEQ = 4096
DEPTH = 4

N_A_LAYERS = DEPTH // 2
N_B_LAYERS = DEPTH - N_A_LAYERS

GLA_HEADS = 4
GLA_QK_DIM = D_MODEL // 2
GLA_V_DIM = D_MODEL
GLA_DK = GLA_QK_DIM // GLA_HEADS
GLA_DV = GLA_V_DIM // GLA_HEADS
GLA_GATE_RANK = 16
GLA_GATE_TAU = 16.0
GLA_CHUNK = 64
GLA_IN_DIM = 2 * GLA_QK_DIM + 2 * GLA_V_DIM + GLA_GATE_RANK

SB_HEADS = 16
SB_HEAD_DIM = D_MODEL // SB_HEADS
SB_DIM = SB_HEADS * SB_HEAD_DIM
SB_Q_BLOCK = 128

D_FF = 4 * D_MODEL
N_MOD = 6
DEEPNORM_ALPHA = (2.0 * DEPTH) ** 0.25
DEEPNORM_BETA = (8.0 * DEPTH) ** -0.25
LN_EPS = 1e-5
RMS_EPS = 1e-5

kernel_name = "yoco_gla_stickbreaking_deepnorm_adaln"


def layer_norm(x, g, b):
    xf = x.astype(jnp.float32)
    mu = jnp.mean(xf, axis=-1, keepdims=True)
    xc = xf - mu
    var = jnp.mean(xc * xc, axis=-1, keepdims=True)
    return (xc * lax.rsqrt(var + LN_EPS) * g.astype(jnp.float32) + b.astype(jnp.float32)).astype(x.dtype)


def gla_mixer(h, w_in, w_gate_up, b_gate, norm_g, w_out):
    B, T, _ = h.shape
    n_chunks = T // GLA_CHUNK
    proj = h @ w_in
    q, k, v, r, gl = jnp.split(
        proj, [GLA_QK_DIM, 2 * GLA_QK_DIM, 2 * GLA_QK_DIM + GLA_V_DIM, 2 * GLA_QK_DIM + 2 * GLA_V_DIM], axis=-1)
    log_a = jax.nn.log_sigmoid((gl @ w_gate_up + b_gate).astype(jnp.float32)) / GLA_GATE_TAU

    def to_chunks(t, d):
        return t.astype(jnp.float32).reshape(B, n_chunks, GLA_CHUNK, GLA_HEADS, d).transpose(0, 3, 1, 2, 4)

    qc = to_chunks(q, GLA_DK) * (GLA_DK ** -0.5)
    kc = to_chunks(k, GLA_DK)
    vc = to_chunks(v, GLA_DV)
    bc = jnp.cumsum(to_chunks(log_a, GLA_DK), axis=3)
    b_last = bc[:, :, :, -1:, :]
    q_dec = qc * jnp.exp(bc)
    k_intra = kc * jnp.exp(-bc)
    k_state = kc * jnp.exp(b_last - bc)
    chunk_decay = jnp.exp(b_last[:, :, :, 0, :])

    causal = jnp.tril(jnp.ones((GLA_CHUNK, GLA_CHUNK), dtype=jnp.float32))
    scores = jnp.einsum('bhncd,bhnsd->bhncs', q_dec, k_intra) * causal
    o_intra = jnp.einsum('bhncs,bhnse->bhnce', scores, vc)

    def step(state, xs):
        qd, ks, vv, dec = xs
        o = jnp.einsum('bhcd,bhde->bhce', qd, state)
        state = state * dec[..., None] + jnp.einsum('bhcd,bhce->bhde', ks, vv)
        return state, o

    xs = (jnp.moveaxis(q_dec, 2, 0), jnp.moveaxis(k_state, 2, 0),
          jnp.moveaxis(vc, 2, 0), jnp.moveaxis(chunk_decay, 2, 0))
    s0 = jnp.zeros((B, GLA_HEADS, GLA_DK, GLA_DV), jnp.float32)
    _, o_inter = lax.scan(step, s0, xs)
    o = o_intra + jnp.moveaxis(o_inter, 0, 2)
    o = o.transpose(0, 2, 3, 1, 4).reshape(B, T, GLA_HEADS, GLA_DV)
    o = o * lax.rsqrt(jnp.mean(o * o, axis=-1, keepdims=True) + RMS_EPS) * norm_g.astype(jnp.float32)
    o = o.reshape(B, T, GLA_V_DIM) * jax.nn.silu(r.astype(jnp.float32))
    return o.astype(h.dtype) @ w_out


def shared_kv(x, cs, kv_ada_w, kv_ada_b, w_kv):
    B, T, _ = x.shape
    mod = (cs @ kv_ada_w + kv_ada_b)[:, None, :]
    shift, scale = jnp.split(mod, 2, axis=-1)
    kv = (x * (1.0 + scale) + shift) @ w_kv
    k, v = jnp.split(kv, 2, axis=-1)
    return (k.reshape(B, T, SB_HEADS, SB_HEAD_DIM), v.reshape(B, T, SB_HEADS, SB_HEAD_DIM))


def stick_breaking_attention(q, k, v):
    B, T, H, dh = q.shape
    nb = T // SB_Q_BLOCK
    qf = (q.astype(jnp.float32) * (dh ** -0.5)).reshape(B, nb, SB_Q_BLOCK, H, dh).transpose(1, 0, 3, 2, 4)
    kf = k.astype(jnp.float32).transpose(0, 2, 1, 3)
    vf = v.astype(jnp.float32).transpose(0, 2, 1, 3)
    k_pos = jnp.arange(T)

    def block(args):
        qb, start = args
        q_pos = start + jnp.arange(SB_Q_BLOCK)
        mask = k_pos[None, :] < q_pos[:, None]
        z = jnp.einsum('bhqd,bhkd->bhqk', qb, kf)
        log_beta = jax.nn.log_sigmoid(z)
        log_not = jnp.where(mask, log_beta - z, 0.0)
        later = lax.cumsum(log_not, axis=3, reverse=True) - log_not
        a = jnp.where(mask, jnp.exp(log_beta + later), 0.0)
        return jnp.einsum('bhqk,bhkd->bhqd', a, vf)

    starts = jnp.arange(nb) * SB_Q_BLOCK
    o = lax.map(block, (qf, starts))
    return o.transpose(1, 0, 3, 2, 4).reshape(B, T, H * dh).astype(q.dtype)


def sb_mixer(h, k, v, w_q, w_out):
    B, T, _ = h.shape
    q = (h @ w_q).reshape(B, T, SB_HEADS, SB_HEAD_DIM)
    return stick_breaking_attention(q, k, v) @ w_out


def sq_relu_mlp(h, w1, b1, w2, b2):
    u = jax.nn.relu(h @ w1 + b1)
    return (u * u) @ w2 + b2


def setup_inputs(seed: int = 0) -> dict:
    key = jax.random.key(seed)
    ks = jax.random.split(key, 24)

    def nrm(k, shape, std):
        return jax.random.normal(k, shape, jnp.float32) * std

    d = D_MODEL
    gla_col_scale = jnp.concatenate([
        jnp.ones((2 * GLA_QK_DIM,), jnp.float32),
        jnp.full((GLA_V_DIM,), DEEPNORM_BETA, jnp.float32),
        jnp.ones((GLA_V_DIM + GLA_GATE_RANK,), jnp.float32)])
    kv_col_scale = jnp.concatenate([
        jnp.ones((SB_DIM,), jnp.float32), jnp.full((SB_DIM,), DEEPNORM_BETA, jnp.float32)])
    return {
        "x": nrm(ks[0], (BATCH, SEQ, d), 1.0),
        "c": nrm(ks[1], (BATCH, d), 1.0),
        "ada_w": nrm(ks[2], (DEPTH, d, N_MOD * d), 0.1 * d ** -0.5),
        "ada_b": nrm(ks[3], (DEPTH, N_MOD * d), 0.01),
        "ln_g": 1.0 + nrm(ks[4], (DEPTH, 2, d), 0.02),
        "ln_b": nrm(ks[5], (DEPTH, 2, d), 0.02),
        "gla_w_in": nrm(ks[6], (N_A_LAYERS, d, GLA_IN_DIM), d ** -0.5) * gla_col_scale,
        "gla_w_gate_up": nrm(ks[7], (N_A_LAYERS, GLA_GATE_RANK, GLA_QK_DIM), GLA_GATE_RANK ** -0.5),
        "gla_b_gate": nrm(ks[8], (N_A_LAYERS, GLA_QK_DIM), 0.5),
        "gla_norm_g": 1.0 + nrm(ks[9], (N_A_LAYERS, GLA_DV), 0.02),
        "gla_w_out": nrm(ks[10], (N_A_LAYERS, GLA_V_DIM, d), DEEPNORM_BETA * GLA_V_DIM ** -0.5),
        "kv_ada_w": nrm(ks[11], (d, 2 * d), 0.1 * d ** -0.5),
        "kv_ada_b": nrm(ks[12], (2 * d,), 0.01),
        "w_kv": nrm(ks[13], (d, 2 * SB_DIM), d ** -0.5) * kv_col_scale,
        "sb_w_q": nrm(ks[14], (N_B_LAYERS, d, SB_DIM), d ** -0.5),
        "sb_w_out": nrm(ks[15], (N_B_LAYERS, SB_DIM, d), DEEPNORM_BETA * SB_DIM ** -0.5),
        "mlp_w1": nrm(ks[16], (DEPTH, d, D_FF), d ** -0.5),
        "mlp_b1": nrm(ks[17], (DEPTH, D_FF), 0.02),
        "mlp_w2": nrm(ks[18], (DEPTH, D_FF, d), DEEPNORM_BETA * D_FF ** -0.5),
        "mlp_b2": nrm(ks[19], (DEPTH, d), 0.02),
    }


def reference(x, c, ada_w, ada_b, ln_g, ln_b, gla_w_in, gla_w_gate_up, gla_b_gate, gla_norm_g,
              gla_w_out, kv_ada_w, kv_ada_b, w_kv, sb_w_q, sb_w_out, mlp_w1, mlp_b1, mlp_w2, mlp_b2):
    cs = jax.nn.silu(c)
    k_shared = None
    v_shared = None
    for l in range(DEPTH):
        mod = (cs @ ada_w[l] + ada_b[l])[:, None, :]
        sh_a, sc_a, g_a, sh_m, sc_m, g_m = jnp.split(mod, N_MOD, axis=-1)
        h = x * (1.0 + sc_a) + sh_a
        if l < N_A_LAYERS:
            y = gla_mixer(h, gla_w_in[l], gla_w_gate_up[l], gla_b_gate[l], gla_norm_g[l], gla_w_out[l])
        else:
            if k_shared is None:
                k_shared, v_shared = shared_kv(x, cs, kv_ada_w, kv_ada_b, w_kv)
            j = l - N_A_LAYERS
            y = sb_mixer(h, k_shared, v_shared, sb_w_q[j], sb_w_out[j])
        x = layer_norm(DEEPNORM_ALPHA * x + (1.0 + g_a) * y, ln_g[l, 0], ln_b[l, 0])
        h = x * (1.0 + sc_m) + sh_m
        y = sq_relu_mlp(h, mlp_w1[l], mlp_b1[l], mlp_w2[l], mlp_b2[l])
        x = layer_norm(DEEPNORM_ALPHA * x + (1.0 + g_m) * y, ln_g[l, 1], ln_b[l, 1])
    return x
```

```cpp
#include <hip/hip_runtime.h>
#include <cstdio>
#include <cstdint>
namespace pg8 {
#define PG8_LAS __attribute__((address_space(3)))
typedef unsigned short bf16_t;
typedef short bf16x8 __attribute__((ext_vector_type(8)));
typedef float f32x4 __attribute__((ext_vector_type(4)));
typedef unsigned u32x4 __attribute__((ext_vector_type(4)));
constexpr int BM = 256, BK = 64, HALF = 128, HTB = HALF * BK * 2  , STAGE_BYTES = 8 * HTB, NXCD = 8, WGM = 8;

__host__ __device__ __forceinline__ int lds_byte(int r, int c) { const int st = (r >> 4) * 2 + (c >> 5), rr = r & 15, cc = c & 31, ob = rr * 64 + cc * 2; return st * 1024 + (ob ^ (((ob >> 9) & 1) << 5)); }
__host__ __device__ __forceinline__ void stage_rc(int b, int& R, int& C) { const int st = b / 1024, sb = b % 1024, swz = sb ^ (((sb >> 9) & 1) << 5); R = (st >> 1) * 16 + swz / 64; C = (st & 1) * 32 + (swz % 64) / 2; }
__host__ __device__ __forceinline__ int perm32(int rho) { const int n = rho >> 4, i = rho & 15; return 8 * (i >> 2) + 4 * n + (i & 3); }

struct Unit { int pm, pn; };
struct Gemm { const bf16_t* A; const bf16_t* Bt; int M, N, K; };

struct StaticOrder {
    int nM, nN, nwg, G, c;
    __host__ __device__ void init(int M, int N, int G_, int c_) { nM = M / BM; nN = N / BM; nwg = nM * nN; G = G_; c = c_; }
    __host__ __device__ bool next(int i, Unit& u) const {
        const long L = (long)i * G + c; if (L >= nwg) return false;
        int wgid = (int)L; { const int q = nwg / NXCD, r = nwg % NXCD, xcd = wgid % NXCD, off = wgid / NXCD; wgid = (xcd < r ? xcd * (q + 1) : r * (q + 1) + (xcd - r) * q) + off; }
        const int nig = WGM * nN, gid = wgid / nig, fm = gid * WGM, gsz = (nM - fm) < WGM ? (nM - fm) : WGM;
        u.pm = fm + ((wgid % nig) % gsz); u.pn = (wgid % nig) / gsz; return true;
    }
    __device__ __forceinline__ void a_ready(const Unit&) const {}
    __device__ __forceinline__ void done(const Unit&) const {}
};

__device__ __forceinline__ unsigned cvt_pk_bf16(float lo, float hi) { unsigned r; asm volatile("v_cvt_pk_bf16_f32 %0, %1, %2" : "=v"(r) : "v"(lo), "v"(hi)); return r; }
typedef float f32x2 __attribute__((ext_vector_type(2)));

struct EpiBf16Seg {
    static constexpr bool PERM = true, AFTER_DRAIN = false;
    bf16_t* O0; bf16_t* O1; bf16_t* O2; int ld0, ld1, ld2, t1, t2; float scale0;
    __device__ __forceinline__ void operator()(const f32x4 (&acc)[2][2][4][2], const Unit& u, int wr, int wc, int fr, int fq) const {
        const int row0 = u.pm * BM + wr * 64 + fr;
        bf16_t* base; int ld, ct; float sc = 1.f;
        if (u.pn < t1) { base = O0; ld = ld0; ct = u.pn; sc = scale0; } else if (u.pn < t2) { base = O1; ld = ld1; ct = u.pn - t1; } else { base = O2; ld = ld2; ct = u.pn - t2; }
        const int col0 = ct * BM + wc * 32 + 8 * fq;
#pragma unroll
        for (int ai = 0; ai < 2; ++ai)
#pragma unroll
            for (int m = 0; m < 4; ++m) { bf16_t* rowp = base + (size_t)(row0 + ai * HALF + m * 16) * ld + col0;
#pragma unroll
                for (int bj = 0; bj < 2; ++bj) { const f32x4 v0 = acc[ai][bj][m][0] * sc, v1 = acc[ai][bj][m][1] * sc;
                    u32x4 w; w.x = cvt_pk_bf16(v0[0], v0[1]); w.y = cvt_pk_bf16(v0[2], v0[3]); w.z = cvt_pk_bf16(v1[0], v1[1]); w.w = cvt_pk_bf16(v1[2], v1[3]);
                    *(u32x4*)(rowp + bj * HALF) = w; } }
    }
};
struct EpiSqRelu {
    static constexpr bool PERM = true, AFTER_DRAIN = false;
    bf16_t* O; int ldc; const float* bias;
    __device__ __forceinline__ void operator()(const f32x4 (&acc)[2][2][4][2], const Unit& u, int wr, int wc, int fr, int fq) const {
        const int row0 = u.pm * BM + wr * 64 + fr, col0 = u.pn * BM + wc * 32 + 8 * fq;
        f32x4 bv[2][2];
#pragma unroll
        for (int bj = 0; bj < 2; ++bj)
#pragma unroll
            for (int n = 0; n < 2; ++n) bv[bj][n] = *(const f32x4*)(bias + col0 + bj * HALF + 4 * n);
#pragma unroll
        for (int ai = 0; ai < 2; ++ai)
#pragma unroll
            for (int m = 0; m < 4; ++m) { bf16_t* rowp = O + (size_t)(row0 + ai * HALF + m * 16) * ldc + col0;
#pragma unroll
                for (int bj = 0; bj < 2; ++bj) { f32x4 v0 = acc[ai][bj][m][0] + bv[bj][0], v1 = acc[ai][bj][m][1] + bv[bj][1];
                    v0 = __builtin_elementwise_max(v0, (f32x4){0.f, 0.f, 0.f, 0.f}); v1 = __builtin_elementwise_max(v1, (f32x4){0.f, 0.f, 0.f, 0.f}); v0 = v0 * v0; v1 = v1 * v1;
                    u32x4 w; w.x = cvt_pk_bf16(v0[0], v0[1]); w.y = cvt_pk_bf16(v0[2], v0[3]); w.z = cvt_pk_bf16(v1[0], v1[1]); w.w = cvt_pk_bf16(v1[2], v1[3]);
                    *(u32x4*)(rowp + bj * HALF) = w; } }
    }
};
struct EpiResid {
    static constexpr bool PERM = false, AFTER_DRAIN = false;
    const float* X; float* Tout; int ldc; const float* bias; const float* gate; int gstride, rows_per_batch; float alpha;
    __device__ __forceinline__ void operator()(const f32x4 (&acc)[2][2][4][2], const Unit& u, int wr, int wc, int fr, int fq) const {
        const int row0 = u.pm * BM + wr * 64 + fr, col0 = u.pn * BM + wc * 32 + 4 * fq;
        const float* gp = gate + (size_t)((u.pm * BM) / rows_per_batch) * gstride + col0;
        f32x4 gv[2][2], bv[2][2];
#pragma unroll
        for (int bj = 0; bj < 2; ++bj)
#pragma unroll
            for (int n = 0; n < 2; ++n) { gv[bj][n] = *(const f32x4*)(gp + bj * HALF + n * 16) + 1.0f; bv[bj][n] = bias ? *(const f32x4*)(bias + col0 + bj * HALF + n * 16) : (f32x4){0.f, 0.f, 0.f, 0.f}; }
#pragma unroll
        for (int ai = 0; ai < 2; ++ai)
#pragma unroll
            for (int m = 0; m < 4; ++m) { const size_t off = (size_t)(row0 + ai * HALF + m * 16) * ldc + col0;
#pragma unroll
                for (int bj = 0; bj < 2; ++bj)
#pragma unroll
                    for (int n = 0; n < 2; ++n) { const f32x4 xs = *(const f32x4*)(X + off + bj * HALF + n * 16);
                        *(f32x4*)(Tout + off + bj * HALF + n * 16) = xs * alpha + gv[bj][n] * (acc[ai][bj][m][n] + bv[bj][n]); }
                if (m & 1) asm volatile("" ::: "memory"); }
    }
};

template <class Epi, class Sched, bool ALIGN_EPI = false, bool SP2 = false>
__device__ __forceinline__ void gemm_phase(PG8_LAS unsigned char* lds, const Gemm g, const Sched& S, const Epi& E) {
    int tid_ = threadIdx.x; asm volatile("" : "+v"(tid_));
    const int tid = tid_, wid = __builtin_amdgcn_readfirstlane(tid >> 6), lane = tid & 63, wr = wid >> 2, wc = wid & 3, fr = lane & 15, fq = lane >> 4;
    const int K = g.K, nt = K / BK;
    unsigned voffA[2], voffB[2];
#pragma unroll
    for (int i = 0; i < 2; ++i) { int R, C; stage_rc(tid * 16 + i * 8192, R, C); const int Rb = Epi::PERM ? ((R & ~31) + perm32(R & 31)) : R;
        voffA[i] = (unsigned)(R * K + C) * 2u; voffB[i] = (unsigned)(Rb * K + C) * 2u; }
    const size_t kstep = (size_t)(BK * 2);
    const size_t hstep = (size_t)HALF * K * 2;
    const size_t tstep = 2 * hstep;
    const unsigned ldsw = (unsigned)wid * 1024u;
    const int aoff = lds_byte(wr * 64 + fr, fq * 8), boff = lds_byte(wc * 32 + fr, fq * 8);
#define PG8_SA(b, h) (((b) * 2 + (h)) * HTB)
#define PG8_SB(b, h) ((4 + (b) * 2 + (h)) * HTB)
#define PG8_STAGE(bufoff, gbase, voff) do { _Pragma("unroll") for (int _i = 0; _i < 2; ++_i) \
        __builtin_amdgcn_global_load_lds((const unsigned*)((const char*)(gbase) + (voff)[_i]), (PG8_LAS unsigned*)(lds + (bufoff) + ldsw + _i * 8192), 16, 0, 0); } while (0)
#define PG8_LDA(dst, b, h) do { _Pragma("unroll") for (int m = 0; m < 4; ++m) _Pragma("unroll") for (int k = 0; k < 2; ++k) dst[m][k] = *(const PG8_LAS bf16x8*)(lds + PG8_SA(b, h) + aoff + m * 2048 + k * 1024); } while (0)
#define PG8_LDB(dst, b, h) do { _Pragma("unroll") for (int n = 0; n < 2; ++n) _Pragma("unroll") for (int k = 0; k < 2; ++k) dst[n][k] = *(const PG8_LAS bf16x8*)(lds + PG8_SB(b, h) + boff + n * 2048 + k * 1024); } while (0)
#define PG8_MMA(ai, bj, At, Bt) do { __builtin_amdgcn_s_setprio(1); _Pragma("unroll") for (int m = 0; m < 4; ++m) _Pragma("unroll") for (int n = 0; n < 2; ++n) _Pragma("unroll") for (int k = 0; k < 2; ++k) \
        acc[ai][bj][m][n] = __builtin_amdgcn_mfma_f32_16x16x32_bf16(Bt[n][k], At[m][k], acc[ai][bj][m][n], 0, 0, 0); __builtin_amdgcn_s_setprio(0); } while (0)
#define PG8_WAIT_V(n) asm volatile("s_waitcnt vmcnt(" #n ")" ::: "memory")
#define PG8_WAIT_L(n) asm volatile("s_waitcnt lgkmcnt(" #n ")" ::: "memory")
#define PG8_BAR __builtin_amdgcn_s_barrier()
#define PG8_SCHED __builtin_amdgcn_sched_barrier(0)
    Unit cur, nxt; int ui = 0;
    if (!S.next(0, cur)) return;
    f32x4 acc[2][2][4][2];
#pragma unroll
    for (int a = 0; a < 2; ++a)
#pragma unroll
        for (int b = 0; b < 2; ++b)
#pragma unroll
            for (int m = 0; m < 4; ++m)
#pragma unroll
                for (int n = 0; n < 2; ++n) acc[a][b][m][n] = (f32x4){0.f, 0.f, 0.f, 0.f};
    bf16x8 At[4][2], B0[2][2], B1[2][2];
    const char* cA = (const char*)g.A + (size_t)cur.pm * tstep; const char* cB = (const char*)g.Bt + (size_t)cur.pn * tstep;
    S.a_ready(cur);
    if constexpr (SP2) {
        PG8_STAGE(PG8_SB(0, 0), cB, voffB); PG8_STAGE(PG8_SB(0, 1), cB + hstep, voffB); PG8_STAGE(PG8_SA(0, 0), cA, voffA); PG8_STAGE(PG8_SA(0, 1), cA + hstep, voffA);
        if (wr == 1) PG8_BAR;
        PG8_WAIT_V(2); PG8_BAR;
        PG8_STAGE(PG8_SB(1, 0), cB + kstep, voffB); PG8_STAGE(PG8_SA(1, 0), cA + kstep, voffA); PG8_STAGE(PG8_SB(1, 1), cB + hstep + kstep, voffB);
        PG8_WAIT_V(6); PG8_BAR;
    } else {
        PG8_STAGE(PG8_SB(0, 0), cB, voffB); PG8_STAGE(PG8_SA(0, 0), cA, voffA); PG8_STAGE(PG8_SB(0, 1), cB + hstep, voffB); PG8_STAGE(PG8_SA(0, 1), cA + hstep, voffA);
        if (wr == 1) PG8_BAR;
        PG8_WAIT_V(4); PG8_BAR;
        PG8_STAGE(PG8_SB(1, 0), cB + kstep, voffB); PG8_STAGE(PG8_SA(1, 0), cA + kstep, voffA); PG8_STAGE(PG8_SB(1, 1), cB + hstep + kstep, voffB);
        PG8_WAIT_V(6); PG8_BAR;
    }
    for (;;) {
        const bool has_next = S.next(ui + 1, nxt);
        const char* nA = has_next ? (const char*)g.A + (size_t)nxt.pm * tstep : cA; const char* nB = has_next ? (const char*)g.Bt + (size_t)nxt.pn * tstep : cB;
        for (int t = 0; t < nt; t += 2) {
            const bool last = (t == nt - 2);
            const char* a1 = cA + (size_t)(t + 1) * kstep;
            const char* a2 = last ? nA : cA + (size_t)(t + 2) * kstep; const char* b2 = last ? nB : cB + (size_t)(t + 2) * kstep;
            const char* a3 = a2 + kstep; const char* b3 = b2 + kstep;
            if (last && has_next) S.a_ready(nxt);
            if constexpr (SP2) {
            PG8_LDB(B0, 0, 0); PG8_LDB(B1, 0, 1); PG8_SCHED; PG8_LDA(At, 0, 0); PG8_STAGE(PG8_SA(1, 1), a1 + hstep, voffA);
            PG8_WAIT_V(8); PG8_WAIT_L(0); PG8_BAR; PG8_MMA(0, 0, At, B0); PG8_MMA(0, 1, At, B1); PG8_BAR; PG8_SCHED;
            PG8_LDA(At, 0, 1); PG8_STAGE(PG8_SB(0, 0), b2, voffB); PG8_STAGE(PG8_SB(0, 1), b2 + hstep, voffB); PG8_STAGE(PG8_SA(0, 0), a2, voffA);
            PG8_WAIT_V(8); PG8_WAIT_L(0); PG8_BAR; PG8_MMA(1, 0, At, B0); PG8_MMA(1, 1, At, B1); PG8_BAR; PG8_SCHED;
            PG8_LDB(B0, 1, 0); PG8_LDB(B1, 1, 1); PG8_SCHED; PG8_LDA(At, 1, 0); PG8_STAGE(PG8_SA(0, 1), a2 + hstep, voffA);
            PG8_WAIT_V(8); PG8_WAIT_L(0); PG8_BAR; PG8_MMA(0, 0, At, B0); PG8_MMA(0, 1, At, B1); PG8_BAR; PG8_SCHED;
            PG8_LDA(At, 1, 1); PG8_STAGE(PG8_SB(1, 0), b3, voffB); PG8_STAGE(PG8_SB(1, 1), b3 + hstep, voffB); PG8_STAGE(PG8_SA(1, 0), a3, voffA);
            PG8_WAIT_V(8); PG8_WAIT_L(0); PG8_BAR; PG8_MMA(1, 0, At, B0); PG8_MMA(1, 1, At, B1); PG8_BAR; PG8_SCHED;
            } else {
            PG8_LDB(B0, 0, 0); PG8_SCHED; PG8_LDA(At, 0, 0); PG8_STAGE(PG8_SA(1, 1), a1 + hstep, voffA);
            PG8_WAIT_L(8); PG8_BAR; PG8_WAIT_L(0); PG8_MMA(0, 0, At, B0); PG8_BAR; PG8_SCHED;
            PG8_LDB(B1, 0, 1); PG8_STAGE(PG8_SB(0, 0), b2, voffB);
            PG8_BAR; PG8_WAIT_L(0); PG8_MMA(0, 1, At, B1); PG8_BAR;
            PG8_LDA(At, 0, 1); PG8_STAGE(PG8_SA(0, 0), a2, voffA);
            PG8_BAR; PG8_WAIT_L(0); PG8_MMA(1, 0, At, B0); PG8_BAR; PG8_SCHED;
            PG8_STAGE(PG8_SB(0, 1), b2 + hstep, voffB);
            PG8_WAIT_V(6); PG8_BAR; PG8_MMA(1, 1, At, B1); PG8_BAR;
            PG8_LDB(B0, 1, 0); PG8_SCHED; PG8_LDA(At, 1, 0); PG8_STAGE(PG8_SA(0, 1), a2 + hstep, voffA);
            PG8_WAIT_L(8); PG8_BAR; PG8_WAIT_L(0); PG8_MMA(0, 0, At, B0); PG8_BAR; PG8_SCHED;
            PG8_LDB(B1, 1, 1); PG8_STAGE(PG8_SB(1, 0), b3, voffB);
            PG8_BAR; PG8_WAIT_L(0); PG8_MMA(0, 1, At, B1); PG8_BAR;
            PG8_LDA(At, 1, 1); PG8_STAGE(PG8_SA(1, 0), a3, voffA);
            PG8_BAR; PG8_WAIT_L(0); PG8_MMA(1, 0, At, B0); PG8_BAR; PG8_SCHED;
            PG8_STAGE(PG8_SB(1, 1), b3 + hstep, voffB);
            PG8_WAIT_V(6); PG8_BAR; PG8_MMA(1, 1, At, B1); PG8_BAR;
            }
        }
        if constexpr (ALIGN_EPI) { if (wr == 0) PG8_BAR; }
        if constexpr (!Epi::AFTER_DRAIN) { E(acc, cur, wr, wc, fr, fq); S.done(cur); }
        if (!has_next) break;
#pragma unroll
        for (int a = 0; a < 2; ++a)
#pragma unroll
            for (int b = 0; b < 2; ++b)
#pragma unroll
                for (int m = 0; m < 4; ++m)
#pragma unroll
                    for (int n = 0; n < 2; ++n) acc[a][b][m][n] = (f32x4){0.f, 0.f, 0.f, 0.f};
        cur = nxt; cA = nA; cB = nB; ++ui;
        if constexpr (ALIGN_EPI) { if (wr == 1) PG8_BAR; }
    }
    PG8_WAIT_V(0);
    if constexpr (!ALIGN_EPI) { if (wr == 0) PG8_BAR; }
    PG8_BAR;
    if constexpr (Epi::AFTER_DRAIN) { E.fused(acc, cur, wr, wc, fr, fq, lds, wid, lane); S.done(cur); }
#undef PG8_SA
#undef PG8_SB
#undef PG8_STAGE
#undef PG8_LDA
#undef PG8_LDB
#undef PG8_MMA
#undef PG8_WAIT_V
#undef PG8_WAIT_L
#undef PG8_BAR
#undef PG8_SCHED
}
}
#ifndef MK_SPLIT
#define MK_SPLIT 0
#endif
#ifndef NAIVE_GLA
#define NAIVE_GLA 1
#endif
#ifndef NAIVE_SB
#define NAIVE_SB 1
#endif
constexpr int NWAVES = 8, NTHREADS = 512;

constexpr int NB = 4, T = 4096, D = 2048, M = NB * T, FF = 8192, DEPTH = 4, NA = 2;
constexpr int GH = 4, GDK = 256, GDV = 512, GQK = 1024, GVD = 2048, GRANK = 16, GCH = 64, GNIN = 6160;
constexpr int SH = 16, SHD = 128;
constexpr int NMOD = 6 * D;
constexpr int NENT = DEPTH * NB * NMOD + NB * 2 * D;
constexpr int KSPLIT = 8;
constexpr float ALPHA = 1.6817928305074290f;
constexpr float LN_EPS = 1e-5f, RMS_EPS = 1e-5f, LOG2E = 1.4426950408889634f;

constexpr size_t MiB = 1u << 20;
constexpr size_t WS_CTL = 0, CTL_ZERO_BYTES = 1 * MiB;
constexpr size_t WS_MOD = 1 * MiB;
constexpr size_t WS_PART = 2 * MiB;
constexpr size_t WS_SSQ = 9 * MiB;
constexpr size_t WS_DECAY = 17 * MiB;
constexpr size_t WS_GL = 18 * MiB;
constexpr size_t WS_WIN = 20 * MiB, WIN_STRIDE = 25 * MiB;
constexpr size_t WS_WGOUT = 70 * MiB;
constexpr size_t WS_WKV = 86 * MiB;
constexpr size_t WS_WQ = 102 * MiB, WS_WSOUT = 118 * MiB;
constexpr size_t WS_W1 = 134 * MiB, WS_W2 = 262 * MiB;
constexpr size_t WS_XA = 390 * MiB, WS_TB = 518 * MiB;
constexpr size_t WS_HA = 646 * MiB, WS_OG = 710 * MiB;
constexpr size_t WS_MIX = 774 * MiB;
constexpr size_t MX_Q = 0, MX_K = 32 * MiB, MX_R = 64 * MiB, MX_VT = 128 * MiB, MX_BC = 192 * MiB, MX_QD = 256 * MiB, MX_KST = 288 * MiB, MX_SM = 320 * MiB;
constexpr size_t MX_SQ = 0, MX_SK = 64 * MiB, MX_SVT = 128 * MiB, MX_HKV = 192 * MiB;
constexpr size_t WS_U = 1166 * MiB, WS_END = 1422 * MiB;
constexpr int CW_TMO = 0, CW_BAR = 4096;

constexpr int RING_OFF = 0, RING_BYTES = 131072;
constexpr int LDSCTL_OFF = 146944, MISC_OFF = LDSCTL_OFF + 320;
constexpr int LDS_BYTES = 147456;

#define GAS __attribute__((address_space(1)))
#define LAS __attribute__((address_space(3)))
typedef unsigned short bf16;
typedef unsigned v4u __attribute__((ext_vector_type(4)));
typedef unsigned v2u __attribute__((ext_vector_type(2)));
typedef float f32x4 __attribute__((ext_vector_type(4)));
typedef short bf16x8 __attribute__((ext_vector_type(8)));
typedef GAS unsigned gu32;
#define RLX_AGENT __ATOMIC_RELAXED, __HIP_MEMORY_SCOPE_AGENT
#define LDS_WAIT() asm volatile("s_waitcnt lgkmcnt(0)" ::: "memory")
__device__ __forceinline__ unsigned f2bf(float f) { unsigned u = __builtin_bit_cast(unsigned, f); return (u + 0x7fffu + ((u >> 16) & 1u)) >> 16; }
__device__ __forceinline__ unsigned pk2(float lo, float hi) { return f2bf(lo) | (f2bf(hi) << 16); }
__device__ __forceinline__ float bf_lo(unsigned w) { return __builtin_bit_cast(float, w << 16); }
__device__ __forceinline__ float bf_hi(unsigned w) { return __builtin_bit_cast(float, w & 0xffff0000u); }
__device__ __forceinline__ float bf1(bf16 h) { return __builtin_bit_cast(float, (unsigned)h << 16); }
__device__ __forceinline__ float wave_sum(float v) {
#pragma unroll
    for (int o = 1; o < 64; o <<= 1) v += __shfl_xor(v, o);
    return v;
}
__device__ __forceinline__ float ex2(float x) { return __builtin_amdgcn_exp2f(x); }
__device__ __forceinline__ float lg2(float x) { return __builtin_amdgcn_logf(x); }
__device__ __forceinline__ float log2_sigmoid(float x) { const float z = x * LOG2E; return fminf(z, 0.f) - lg2(1.f + ex2(-fabsf(z))); }

#define XB_TMO      128
#define XB_XCNT(j)  (256  + 64 * (j))
#define XB_XSUB(j)  (1280 + 64 * (j))
#define XB_XGEN(j)  (2304 + 64 * (j))
#define XB_TOP      3328
#define XB_TOPGEN   3392
#define XCD_BAR_WORDS 3456
#define XB_SPIN_CAP (1u << 18)

__device__ __forceinline__ unsigned xb_ld(unsigned* p)              { return __hip_atomic_load(p, __ATOMIC_RELAXED, __HIP_MEMORY_SCOPE_AGENT); }
__device__ __forceinline__ unsigned xb_add(unsigned* p, unsigned v) { return __hip_atomic_fetch_add(p, v, __ATOMIC_RELAXED, __HIP_MEMORY_SCOPE_AGENT); }
__device__ __forceinline__ unsigned xb_xcc_id() { return (unsigned)__builtin_amdgcn_s_getreg((3 << 11) | 20) & 0xFu; }
#define XB_SPIN(cond, bar) do { unsigned _sp = 0; while (cond) { __builtin_amdgcn_s_sleep(1); \
    if ((++_sp & 255u) == 0u) { if (xb_ld(&(bar)[XB_TMO])) break; if (_sp > XB_SPIN_CAP) { atomicAdd(&(bar)[XB_TMO], 1u); break; } } } } while (0)

struct XcdBarrier {
    unsigned* bar; unsigned x;
    volatile LAS unsigned* st;
};

__device__ __forceinline__ XcdBarrier xcd_barrier_post(unsigned* bar, volatile LAS unsigned* st) {
    XcdBarrier b; b.bar = bar; b.x = xb_xcc_id(); b.st = st;
    if (threadIdx.x == 0) (void)xb_add(&bar[XB_XCNT(b.x)], 1u);
    return b;
}
__device__ __forceinline__ void xcd_barrier_complete(unsigned* bar, unsigned x, unsigned& nloc, unsigned& nx) {
    const unsigned G = gridDim.x * gridDim.y * gridDim.z;
    unsigned sum, cnt, mine, sp = 0u;
    for (;;) {
        sum = 0u; cnt = 0u; mine = 0u;
#pragma unroll
        for (unsigned j = 0; j < 16; ++j) { const unsigned c = xb_ld(&bar[XB_XCNT(j)]); sum += c; cnt += (c > 0u) ? 1u : 0u; mine = (j == x) ? c : mine; }
        if (sum == G) break;
        __builtin_amdgcn_s_sleep(1);
        if ((++sp & 255u) == 0u) { if (xb_ld(&bar[XB_TMO])) break; if (sp > XB_SPIN_CAP) { atomicAdd(&bar[XB_TMO], 1u); break; } }
    }
    nloc = mine > 0u ? mine : 1u; nx = cnt > 0u ? cnt : 1u;
}

__device__ __forceinline__ void xcd_barrier(const XcdBarrier& b) {
    asm volatile("s_waitcnt vmcnt(0)" ::: "memory");
    __syncthreads();
    if (threadIdx.x == 0) {
        unsigned* bar = b.bar;
        __builtin_amdgcn_s_waitcnt(0);
        unsigned nloc = b.st[0], nx = b.st[1];
        if (nloc == 0u) { xcd_barrier_complete(bar, b.x, nloc, nx); b.st[0] = nloc; b.st[1] = nx; }
        const unsigned old = xb_add(&bar[XB_XSUB(b.x)], 1u);
        const unsigned gen = old / nloc;
        if (old + 1u == (gen + 1u) * nloc) {
            __builtin_amdgcn_fence(__ATOMIC_RELEASE, "agent");
            asm volatile("s_waitcnt vmcnt(0)" ::: "memory");
            const unsigned og = xb_add(&bar[XB_TOP], 1u);
            const unsigned tg = og / nx;
            if (og + 1u == (tg + 1u) * nx) xb_add(&bar[XB_TOPGEN], 1u);
            else XB_SPIN(xb_ld(&bar[XB_TOPGEN]) == tg, bar);
            __builtin_amdgcn_fence(__ATOMIC_ACQUIRE, "agent");
            xb_add(&bar[XB_XGEN(b.x)], 1u);
            asm volatile("s_waitcnt vmcnt(0)" ::: "memory");
        } else {
            XB_SPIN(xb_ld(&bar[XB_XGEN(b.x)]) == gen, bar);
            __builtin_amdgcn_fence(__ATOMIC_ACQUIRE, "agent");
            asm volatile("s_waitcnt vmcnt(0)" ::: "memory");
        }
    }
    __syncthreads();
}
struct Args { const float* in[20]; float* out; unsigned char* ws; int ph_lo, ph_hi, li, pad; };
struct Frame {
    LAS unsigned char* lds;
    volatile LAS unsigned* MISC;
    gu32* ctl;
    int tid, lane, wave, vcu, G;
    unsigned char* ws;
};
enum { IN_X = 0, IN_C, IN_ADAW, IN_ADAB, IN_LNG, IN_LNB, IN_GWIN, IN_GWUP, IN_GBG, IN_GNG, IN_GWOUT, IN_KVADAW, IN_KVADAB, IN_WKV, IN_SWQ, IN_SWOUT, IN_W1, IN_B1, IN_W2, IN_B2 };
__device__ __forceinline__ const float* mod_vec(const Frame& F, int l, int b, int chunk) { return (const float*)(F.ws + WS_MOD) + (size_t)(l * NB + b) * NMOD + chunk * D; }

__device__ __forceinline__ void tr_item(const float* W, int ldw, int K, bf16* WT, int k0, int n0s, int nd0, LAS float* scr, int lane) {
    const int lr = lane >> 4, lc = 4 * (lane & 15);
#pragma unroll
    for (int i = 0; i < 16; ++i) { const int kk = 4 * i + lr; const f32x4 v = *(const f32x4*)(W + (size_t)(k0 + kk) * ldw + n0s + lc);
        LAS float* s = scr + kk * 65 + lc; s[0] = v[0]; s[1] = v[1]; s[2] = v[2]; s[3] = v[3]; }
    LDS_WAIT(); asm volatile("" ::: "memory");
    const int c = lane & 7;
#pragma unroll
    for (int j = 0; j < 8; ++j) { const int n = (lane >> 3) + 8 * j; const LAS float* s = scr + (8 * c) * 65 + n;
        v4u o; o.x = pk2(s[0 * 65], s[1 * 65]); o.y = pk2(s[2 * 65], s[3 * 65]); o.z = pk2(s[4 * 65], s[5 * 65]); o.w = pk2(s[6 * 65], s[7 * 65]);
        *(v4u*)(WT + (size_t)(nd0 + n) * K + k0 + 8 * c) = o; }
    LDS_WAIT(); asm volatile("" ::: "memory");
}
__device__ __forceinline__ void tr_matrix_item(const float* W, int ldw, int K, int N, bf16* WT, int item, int remap_win, LAS float* scr, int lane) {
    const int nblk = N / 64, kb = item / nblk, nb = item % nblk; int nd0 = 64 * nb;
    if (remap_win) { if (nd0 >= 2048 && nd0 < 4096) nd0 += 2048; else if (nd0 >= 4096) nd0 -= 2048; }
    tr_item(W, ldw, K, WT, 64 * kb, 64 * nb, nd0, scr, lane);
}
__device__ __forceinline__ void ph_pro0(Frame& F, const Args& a) {
    LAS float* cs = (LAS float*)(F.lds);
    for (int i = F.tid; i < NB * D; i += NTHREADS) { const float v = a.in[IN_C][i]; cs[i] = v / (1.f + __expf(-v)); }
    __syncthreads();
    const int gw = F.vcu * NWAVES + F.wave, NGW = F.G * NWAVES;
    for (int task = gw; task < 208 * KSPLIT; task += NGW) {
        const int cb = task / KSPLIT, ks = task % KSPLIT;
        const float* src; int ld, j0, ebase, estride;
        if (cb < 192) { const int l = cb / 48, jb = cb % 48; src = a.in[IN_ADAW] + (size_t)l * D * NMOD; ld = NMOD; j0 = jb * 256 + F.lane * 4; ebase = l * NB * NMOD; estride = NMOD; }
        else { const int jb = cb - 192; src = a.in[IN_KVADAW]; ld = 2 * D; j0 = jb * 256 + F.lane * 4; ebase = DEPTH * NB * NMOD; estride = 2 * D; }
        f32x4 acc[NB];
#pragma unroll
        for (int b = 0; b < NB; ++b) acc[b] = (f32x4){0.f, 0.f, 0.f, 0.f};
        const float* p = src + (size_t)(ks * 256) * ld + j0; const LAS float* cp = cs + ks * 256;
#pragma unroll 8
        for (int k = 0; k < 256; ++k) { const f32x4 w = *(const f32x4*)(p + (size_t)k * ld);
#pragma unroll
            for (int b = 0; b < NB; ++b) acc[b] += w * cp[b * D + k]; }
        float* part = (float*)(F.ws + WS_PART) + (size_t)ks * NENT + ebase + j0;
#pragma unroll
        for (int b = 0; b < NB; ++b) *(f32x4*)(part + (size_t)b * estride) = acc[b];
    }
    __syncthreads();
    LAS float* scr = (LAS float*)(F.lds + F.wave * 16640);
    constexpr int I_WIN = 32 * 96, I_SQ = 32 * 32, I_KV = 32 * 64, I_W1 = 32 * 128, I_W2 = 128 * 32;
    constexpr int NITEMS = 2 * I_WIN + 2 * I_SQ + I_KV + 2 * I_SQ + 2 * I_SQ + 4 * I_W1 + 4 * I_W2;
    for (int it = gw; it < NITEMS; it += NGW) {
        int r = it;
        if (r < 2 * I_WIN) { const int l = r / I_WIN; tr_matrix_item(a.in[IN_GWIN] + (size_t)l * D * GNIN, GNIN, D, 6144, (bf16*)(F.ws + WS_WIN + l * WIN_STRIDE), r % I_WIN, 1, scr, F.lane); continue; } r -= 2 * I_WIN;
        if (r < 2 * I_SQ) { const int l = r / I_SQ; tr_matrix_item(a.in[IN_GWOUT] + (size_t)l * D * D, D, D, D, (bf16*)(F.ws + WS_WGOUT) + (size_t)l * D * D, r % I_SQ, 0, scr, F.lane); continue; } r -= 2 * I_SQ;
        if (r < I_KV) { tr_matrix_item(a.in[IN_WKV], 2 * D, D, 2 * D, (bf16*)(F.ws + WS_WKV), r, 0, scr, F.lane); continue; } r -= I_KV;
        if (r < 2 * I_SQ) { const int l = r / I_SQ; tr_matrix_item(a.in[IN_SWQ] + (size_t)l * D * D, D, D, D, (bf16*)(F.ws + WS_WQ) + (size_t)l * D * D, r % I_SQ, 0, scr, F.lane); continue; } r -= 2 * I_SQ;
        if (r < 2 * I_SQ) { const int l = r / I_SQ; tr_matrix_item(a.in[IN_SWOUT] + (size_t)l * D * D, D, D, D, (bf16*)(F.ws + WS_WSOUT) + (size_t)l * D * D, r % I_SQ, 0, scr, F.lane); continue; } r -= 2 * I_SQ;
        if (r < 4 * I_W1) { const int l = r / I_W1; tr_matrix_item(a.in[IN_W1] + (size_t)l * D * FF, FF, D, FF, (bf16*)(F.ws + WS_W1) + (size_t)l * D * FF, r % I_W1, 0, scr, F.lane); continue; } r -= 4 * I_W1;
        { const int l = r / I_W2; tr_matrix_item(a.in[IN_W2] + (size_t)l * D * FF, D, FF, D, (bf16*)(F.ws + WS_W2) + (size_t)l * D * FF, r % I_W2, 0, scr, F.lane); }
    }
    for (int idx = blockIdx.x * NTHREADS + F.tid; idx < NA * 16 * 256; idx += F.G * NTHREADS) {
        const int l = idx / 4096, n = (idx % 4096) / 256, kc = idx % 256;
        const float* s = a.in[IN_GWIN] + (size_t)l * D * GNIN + (size_t)(8 * kc) * GNIN + 6144 + n;
        v4u o; o.x = pk2(s[0], s[GNIN]); o.y = pk2(s[2 * GNIN], s[3 * GNIN]); o.z = pk2(s[4 * GNIN], s[5 * GNIN]); o.w = pk2(s[6 * GNIN], s[7 * GNIN]);
        *(v4u*)((bf16*)(F.ws + WS_WIN + l * WIN_STRIDE) + (size_t)(6144 + n) * D + 8 * kc) = o;
    }
}

__device__ __forceinline__ float mod_entry(const Frame& F, const Args& a, int e) {
    float s = (e < DEPTH * NB * NMOD) ? a.in[IN_ADAB][(e / (NB * NMOD)) * NMOD + e % NMOD] : a.in[IN_KVADAB][(e - DEPTH * NB * NMOD) % (2 * D)];
    const float* part = (const float*)(F.ws + WS_PART) + e;
#pragma unroll
    for (int ks = 0; ks < KSPLIT; ++ks) s += part[(size_t)ks * NENT];
    return s;
}
__device__ __forceinline__ void ph_pro1(Frame& F, const Args& a) {
    float* MOD = (float*)(F.ws + WS_MOD);
    constexpr int PER = NENT / 256;
    for (int s = blockIdx.x; s < 256; s += F.G) for (int e = s * PER + F.tid; e < (s + 1) * PER; e += NTHREADS) MOD[e] = mod_entry(F, a, e);
    const int b = (blockIdx.x * 64) / T;
    LAS float* lsh = (LAS float*)F.lds; LAS float* lsc = lsh + D;
    for (int j = F.tid; j < 2 * D; j += NTHREADS) lsh[j] = mod_entry(F, a, b * NMOD + j);
    __syncthreads();
    for (int i = 0; i < 8; ++i) {
        const int m = blockIdx.x * 64 + F.wave * 8 + i;
        const f32x4* xr = (const f32x4*)(a.in[IN_X] + (size_t)m * D) + F.lane; v2u* ho = (v2u*)((bf16*)(F.ws + WS_HA) + (size_t)m * D) + F.lane;
#pragma unroll
        for (int j = 0; j < 8; ++j) { const f32x4 x = xr[64 * j]; const int c = 4 * F.lane + 256 * j;
            const f32x4 sc = *(const LAS f32x4*)(lsc + c), sh = *(const LAS f32x4*)(lsh + c); const f32x4 h = x * (sc + 1.0f) + sh;
            v2u o; o.x = pk2(h[0], h[1]); o.y = pk2(h[2], h[3]); ho[64 * j] = o; }
    }
}

__device__ __forceinline__ void ph_ln(Frame& F, const float* Tin, float* Xout, const float* g, const float* bta, const float* sc, const float* sh, int bstride, bf16* Hout,
                                      const float* sc2, const float* sh2, int bstride2, bf16* H2out) {
    const int b = (blockIdx.x * 64) / T;
    f32x4 gA[8], bA[8], hA[8], hB[8];
#pragma unroll
    for (int j = 0; j < 8; ++j) { const int c = 4 * F.lane + 256 * j; gA[j] = *(const f32x4*)(g + c); bA[j] = *(const f32x4*)(bta + c);
        if (Hout) { const f32x4 s1 = *(const f32x4*)(sc + (size_t)b * bstride + c) + 1.0f, s0 = *(const f32x4*)(sh + (size_t)b * bstride + c); hA[j] = gA[j] * s1; hB[j] = bA[j] * s1 + s0; }
        else { hA[j] = gA[j]; hB[j] = bA[j]; } }
    for (int i = 0; i < 8; ++i) {
        const int m = blockIdx.x * 64 + F.wave * 8 + i;
        const f32x4* tr = (const f32x4*)(Tin + (size_t)m * D) + F.lane;
        f32x4 v[8]; float s = 0.f;
#pragma unroll
        for (int j = 0; j < 8; ++j) { v[j] = tr[64 * j]; s += (v[j][0] + v[j][1]) + (v[j][2] + v[j][3]); }
        const float mean = wave_sum(s) * (1.f / D); float s2 = 0.f;
#pragma unroll
        for (int j = 0; j < 8; ++j) { v[j] = v[j] - mean; s2 += (v[j][0] * v[j][0] + v[j][1] * v[j][1]) + (v[j][2] * v[j][2] + v[j][3] * v[j][3]); }
        const float rstd = 1.f / sqrtf(wave_sum(s2) * (1.f / D) + LN_EPS);
        f32x4* xo = (f32x4*)(Xout + (size_t)m * D) + F.lane;
#pragma unroll
        for (int j = 0; j < 8; ++j) { v[j] = v[j] * rstd; xo[64 * j] = v[j] * gA[j] + bA[j]; }
        if (Hout) { v2u* ho = (v2u*)(Hout + (size_t)m * D) + F.lane;
#pragma unroll
            for (int j = 0; j < 8; ++j) { const f32x4 h = v[j] * hA[j] + hB[j]; v2u o; o.x = pk2(h[0], h[1]); o.y = pk2(h[2], h[3]); ho[64 * j] = o; } }
        if (H2out) { v2u* ho = (v2u*)(H2out + (size_t)m * D) + F.lane;
#pragma unroll
            for (int j = 0; j < 8; ++j) { const int c = 4 * F.lane + 256 * j; const f32x4 x = v[j] * gA[j] + bA[j];
                const f32x4 h = x * (*(const f32x4*)(sc2 + (size_t)b * bstride2 + c) + 1.0f) + *(const f32x4*)(sh2 + (size_t)b * bstride2 + c);
                v2u o; o.x = pk2(h[0], h[1]); o.y = pk2(h[2], h[3]); ho[64 * j] = o; } }
    }
}

template <class Epi> __device__ __forceinline__ void run_gemm(Frame& F, const bf16* A, const bf16* Bt, int M_, int N_, int K_, const Epi& E) {
    pg8::Gemm g{A, Bt, M_, N_, K_}; pg8::StaticOrder S; S.init(M_, N_, F.G, (int)blockIdx.x);
    pg8::gemm_phase<Epi, pg8::StaticOrder, true, true>(F.lds + RING_OFF, g, S, E);
}

__device__ __forceinline__ void ph_normgate(Frame& F, const float* O, const float* SSQ, const bf16* R, const float* ng, bf16* OG) {
    f32x4 gv[8];
#pragma unroll
    for (int j = 0; j < 8; ++j) gv[j] = *(const f32x4*)(ng + (4 * F.lane + 256 * j) % GDV);
    for (int i = 0; i < 8; ++i) {
        const int m = blockIdx.x * 64 + F.wave * 8 + i;
        float q0 = SSQ[(size_t)m * 128 + F.lane], q1 = SSQ[(size_t)m * 128 + 64 + F.lane];
#pragma unroll
        for (int o = 1; o < 32; o <<= 1) { q0 += __shfl_xor(q0, o); q1 += __shfl_xor(q1, o); }
        float rs[4]; rs[0] = __shfl(q0, 0); rs[1] = __shfl(q0, 32); rs[2] = __shfl(q1, 0); rs[3] = __shfl(q1, 32);
#pragma unroll
        for (int h = 0; h < 4; ++h) rs[h] = 1.f / sqrtf(rs[h] * (1.f / GDV) + RMS_EPS);
        const f32x4* orow = (const f32x4*)(O + (size_t)m * D) + F.lane; const v2u* rrow = (const v2u*)(R + (size_t)m * D) + F.lane; v2u* og = (v2u*)(OG + (size_t)m * D) + F.lane;
#pragma unroll
        for (int j = 0; j < 8; ++j) { const f32x4 o = orow[64 * j]; const v2u rw = rrow[64 * j]; const float sc = rs[j >> 1];
            float r[4] = {bf_lo(rw.x), bf_hi(rw.x), bf_lo(rw.y), bf_hi(rw.y)}; float y[4];
#pragma unroll
            for (int q = 0; q < 4; ++q) y[q] = o[q] * sc * gv[j][q] * (r[q] / (1.f + __expf(-r[q])));
            v2u w; w.x = pk2(y[0], y[1]); w.y = pk2(y[2], y[3]); og[64 * j] = w; }
    }
}

#if NAIVE_GLA
__device__ __forceinline__ void ph_naive_gl(Frame& F, const bf16* HA, const bf16* Wgl, float* GL) {
    for (int i = 0; i < 8; ++i) {
        const int m = blockIdx.x * 64 + F.wave * 8 + i;
        v4u hv[4];
#pragma unroll
        for (int q = 0; q < 4; ++q) hv[q] = *(const v4u*)(HA + (size_t)m * D + F.lane * 8 + 512 * q);
        float mine = 0.f;
#pragma unroll 1
        for (int j = 0; j < 16; ++j) { float acc = 0.f;
#pragma unroll
            for (int q = 0; q < 4; ++q) { const v4u wv = *(const v4u*)(Wgl + (size_t)j * D + F.lane * 8 + 512 * q); const v4u h = hv[q];
                acc += bf_lo(h.x) * bf_lo(wv.x) + bf_hi(h.x) * bf_hi(wv.x) + bf_lo(h.y) * bf_lo(wv.y) + bf_hi(h.y) * bf_hi(wv.y) + bf_lo(h.z) * bf_lo(wv.z) + bf_hi(h.z) * bf_hi(wv.z) + bf_lo(h.w) * bf_lo(wv.w) + bf_hi(h.w) * bf_hi(wv.w); }
            acc = wave_sum(acc); if (F.lane == j) mine = acc; }
        if (F.lane < 16) GL[(size_t)m * 16 + F.lane] = mine;
    }
}
__device__ __forceinline__ void ph_naive_gla(Frame& F, const Args& a, int l, const bf16* Q, const bf16* Kk, const bf16* VT, const float* GL, float* O, float* SSQ) {
    const int blk = blockIdx.x, b = blk / 64, h = (blk / 16) % 4, eg = blk % 16, d = F.tid & 255, eh = F.tid >> 8;
    LAS float* P = (LAS float*)F.lds;
    LAS bf16* vbuf = (LAS bf16*)(F.lds + 36864);
    LAS float* osq = (LAS float*)(F.lds + 36864 + 4096);
    float wup[16];
#pragma unroll
    for (int j = 0; j < 16; ++j) wup[j] = a.in[IN_GWUP][(size_t)l * GRANK * GQK + j * GQK + h * GDK + d];
    const float bg = a.in[IN_GBG][l * GQK + h * GDK + d];
    float S[16];
#pragma unroll
    for (int i = 0; i < 16; ++i) S[i] = 0.f;
    for (int t0 = 0; t0 < T; t0 += 64) {
        __syncthreads();
        if (F.tid < 256) { const int row = F.tid >> 3, piece = F.tid & 7;
            *(LAS v4u*)(vbuf + row * 64 + piece * 8) = *(const v4u*)(VT + (size_t)(h * GDV + eg * 32 + row) * M + (size_t)b * T + t0 + piece * 8); }
        __syncthreads();
        for (int tt = 0; tt < 64; ++tt) {
            const int m = b * T + t0 + tt;
            float x = bg;
#pragma unroll
            for (int j = 0; j < 16; ++j) x += GL[(size_t)m * 16 + j] * wup[j];
            const float aa = ex2(log2_sigmoid(x) * (1.f / 16.f));
            const float kd = bf1(Kk[(size_t)m * GQK + h * GDK + d]), qd = bf1(Q[(size_t)m * GQK + h * GDK + d]) * 0.0625f;
#pragma unroll
            for (int i = 0; i < 16; ++i) { S[i] = aa * S[i] + kd * bf1(vbuf[(eh * 16 + i) * 64 + tt]); P[(eh * 16 + i) * 257 + d] = qd * S[i]; }
            __syncthreads();
            { const int e = F.tid >> 4, part = F.tid & 15; float s = 0.f;
#pragma unroll
                for (int k = 0; k < 16; ++k) s += P[e * 257 + part * 16 + k];
                s += __shfl_xor(s, 1); s += __shfl_xor(s, 2); s += __shfl_xor(s, 4); s += __shfl_xor(s, 8);
                if (part == 0) { O[(size_t)m * D + h * GDV + eg * 32 + e] = s; osq[e] = s * s; } }
            __syncthreads();
            if (F.tid < 2) { float q = 0.f;
#pragma unroll
                for (int k = 0; k < 16; ++k) q += osq[F.tid * 16 + k];
                SSQ[(size_t)m * 128 + h * 32 + eg * 2 + F.tid] = q; }
        }
    }
}
#endif

#if NAIVE_SB
__device__ __forceinline__ void ph_naive_sb(Frame& F, const bf16* Q, const bf16* Kk, const bf16* VT, bf16* OG) {
    const int gw = blockIdx.x * NWAVES + F.wave, NGW = F.G * NWAVES;
    for (int row = gw; row < NB * SH * T; row += NGW) {
        const int t = row % T, h = (row / T) % SH, b = row / (T * SH);
        const size_t mq = (size_t)b * T + t;
        const unsigned qw = *(const unsigned*)(Q + mq * D + h * SHD + 2 * F.lane); const float q0 = bf_lo(qw), q1 = bf_hi(qw);
        const bf16* vt0 = VT + (size_t)(h * SHD + 2 * F.lane) * M + (size_t)b * T;
        float acc0 = 0.f, acc1 = 0.f, carry = 0.f;
        for (int s0 = t - 1; s0 >= 0 && carry > -170.f; s0 -= 8) {
#pragma unroll
            for (int u = 0; u < 8; ++u) { const int s = s0 - u; if (s >= 0) {
                const unsigned kw = *(const unsigned*)(Kk + ((size_t)b * T + s) * D + h * SHD + 2 * F.lane);
                const float z = wave_sum(q0 * bf_lo(kw) + q1 * bf_hi(kw));
                const float L = lg2(1.f + ex2(-fabsf(z))), lb = fminf(z, 0.f) - L, ln = fminf(-z, 0.f) - L;
                const float aw = ex2(lb + carry); carry += ln;
                acc0 += aw * bf1(vt0[s]); acc1 += aw * bf1(vt0[M + s]); } }
        }
        *(unsigned*)(OG + mq * D + h * SHD + 2 * F.lane) = pk2(acc0, acc1);
    }
}
#endif
#ifndef PHMASK
#define PHMASK 0xFFFFFFFFu
#endif
#define ON(k) (((PHMASK) >> (k)) & 1u)
constexpr int N_PHASES = 2 + NA * ((NAIVE_GLA ? 4 : 4) + 5) + (DEPTH - NA) * (2 + 5);
__global__ void __launch_bounds__(NTHREADS, 2) yoco_fwd(Args args) {
    extern __shared__ __attribute__((aligned(16))) unsigned char lds[];
    Frame F;
    F.lds = (LAS unsigned char*)lds;
    F.MISC = (volatile LAS unsigned*)(F.lds + MISC_OFF);
    F.tid = threadIdx.x; F.lane = F.tid & 63; F.wave = __builtin_amdgcn_readfirstlane(F.tid >> 6);
    F.G = gridDim.x; { const int bx = blockIdx.x; F.vcu = (F.G % 8 == 0) ? (bx % 8) * (F.G / 8) + bx / 8 : bx; }
    F.ws = args.ws; F.ctl = (gu32*)(args.ws + WS_CTL);
    for (int u = F.tid; u < (LDS_BYTES - LDSCTL_OFF) / 4; u += NTHREADS) ((LAS unsigned*)(F.lds + LDSCTL_OFF))[u] = 0u;
    __syncthreads();
    const int lo = args.ph_lo, hi = args.ph_hi;
    XcdBarrier bar; bar.bar = (unsigned*)(F.ctl + CW_BAR) + args.li * XCD_BAR_WORDS; bar.x = 0; bar.st = nullptr;
    if (hi - lo > 1) bar = xcd_barrier_post((unsigned*)(F.ctl + CW_BAR) + args.li * XCD_BAR_WORDS, F.MISC + 8);
    int pc = 0;
#define PHASE_BEGIN if (pc >= lo && pc < hi) { { int t_ = threadIdx.x; asm volatile("" : "+v"(t_)); F.tid = t_; F.lane = t_ & 63; }
#define PHASE_END   if (pc + 1 < hi) xcd_barrier(bar); } ++pc;

    unsigned char* ws = args.ws;
    float* XA = (float*)(ws + WS_XA); float* TB = (float*)(ws + WS_TB);
    bf16* HA = (bf16*)(ws + WS_HA); bf16* OG = (bf16*)(ws + WS_OG); bf16* U = (bf16*)(ws + WS_U);
    unsigned char* mix = ws + WS_MIX;

    PHASE_BEGIN if constexpr (ON(0)) ph_pro0(F, args); PHASE_END
    PHASE_BEGIN if constexpr (ON(1)) ph_pro1(F, args); PHASE_END

    for (int l = 0; l < DEPTH; ++l) {
        const float* xcur = (l == 0) ? args.in[IN_X] : XA;
        const bf16* wout_t;
        if (l < NA) {
            bf16* win_t = (bf16*)(ws + WS_WIN + (size_t)l * WIN_STRIDE);
            bf16* Q = (bf16*)(mix + MX_Q); bf16* Kk = (bf16*)(mix + MX_K); bf16* R = (bf16*)(mix + MX_R); bf16* VT = (bf16*)(mix + MX_VT);
            float* SSQ = (float*)(ws + WS_SSQ);
            PHASE_BEGIN
                if constexpr (ON(2)) { pg8::EpiBf16Seg E{Q, Kk, R, GQK, GQK, GVD, 4, 8, 1.0f}; run_gemm(F, HA, win_t, M, 4096, D, E); }
                if constexpr (ON(2)) { pg8::EpiBf16Seg E{VT, VT, VT, M, M, M, 1 << 20, 1 << 20, 1.0f}; run_gemm(F, win_t + (size_t)4096 * D, HA, GVD, M, D, E); }
#if NAIVE_GLA
                if constexpr (ON(3)) ph_naive_gl(F, HA, win_t + (size_t)6144 * D, (float*)(ws + WS_GL));
#endif
            PHASE_END
#if NAIVE_GLA
            PHASE_BEGIN if constexpr (ON(4)) ph_naive_gla(F, args, l, Q, Kk, VT, (const float*)(ws + WS_GL), TB, SSQ); PHASE_END
            PHASE_BEGIN PHASE_END
#endif
            PHASE_BEGIN if constexpr (ON(5)) ph_normgate(F, TB, SSQ, R, args.in[IN_GNG] + l * GDV, OG); PHASE_END
            wout_t = (const bf16*)(ws + WS_WGOUT) + (size_t)l * D * D;
        } else {
            const int j = l - NA;
            bf16* SQ = (bf16*)(mix + MX_SQ); bf16* SK = (bf16*)(mix + MX_SK); bf16* SVT = (bf16*)(mix + MX_SVT); bf16* HKV = (bf16*)(mix + MX_HKV);
            PHASE_BEGIN if constexpr (ON(6)) {
                const int ncall = (j == 0) ? 3 : 1;
                for (int c = 0; c < ncall; ++c) {
                    const bf16* A_ = (c == 0) ? HA : (c == 1) ? HKV : (const bf16*)(ws + WS_WKV) + (size_t)D * D;
                    const bf16* B_ = (c == 0) ? (const bf16*)(ws + WS_WQ) + (size_t)j * D * D : (c == 1) ? (const bf16*)(ws + WS_WKV) : HKV;
                    bf16* O_ = (c == 0) ? SQ : (c == 1) ? SK : SVT;
                    const int M_ = (c == 2) ? D : M, N_ = (c == 2) ? M : D;
                    pg8::EpiBf16Seg E{O_, O_, O_, N_, N_, N_, 1 << 20, 1 << 20, (c == 0) ? LOG2E * 0.08838834764831845f : 1.0f}; run_gemm(F, A_, B_, M_, N_, D, E);
                } }
            PHASE_END
#if NAIVE_SB
            PHASE_BEGIN if constexpr (ON(7)) ph_naive_sb(F, SQ, SK, SVT, OG); PHASE_END
#endif
            wout_t = (const bf16*)(ws + WS_WSOUT) + (size_t)j * D * D;
        }
        PHASE_BEGIN if constexpr (ON(8)) { pg8::EpiResid E{xcur, TB, D, nullptr, mod_vec(F, l, 0, 2), NMOD, T, ALPHA}; run_gemm(F, OG, wout_t, M, D, D, E); } PHASE_END
        PHASE_BEGIN if constexpr (ON(9)) ph_ln(F, TB, XA, args.in[IN_LNG] + (size_t)(l * 2 + 0) * D, args.in[IN_LNB] + (size_t)(l * 2 + 0) * D, mod_vec(F, l, 0, 4), mod_vec(F, l, 0, 3), NMOD, HA, nullptr, nullptr, 0, nullptr); PHASE_END
        PHASE_BEGIN if constexpr (ON(10)) { pg8::EpiSqRelu E{U, FF, args.in[IN_B1] + (size_t)l * FF}; run_gemm(F, HA, (const bf16*)(ws + WS_W1) + (size_t)l * D * FF, M, FF, D, E); } PHASE_END
        PHASE_BEGIN if constexpr (ON(11)) { pg8::EpiResid E{XA, TB, D, args.in[IN_B2] + (size_t)l * D, mod_vec(F, l, 0, 5), NMOD, T, ALPHA}; run_gemm(F, U, (const bf16*)(ws + WS_W2) + (size_t)l * D * FF, M, D, FF, E); } PHASE_END
        PHASE_BEGIN if constexpr (ON(12)) {
            const bool last = (l == DEPTH - 1); const int ln = last ? l : l + 1;
            const float* kvm = (const float*)(ws + WS_MOD) + (size_t)DEPTH * NB * NMOD;
            ph_ln(F, TB, last ? args.out : XA, args.in[IN_LNG] + (size_t)(l * 2 + 1) * D, args.in[IN_LNB] + (size_t)(l * 2 + 1) * D, mod_vec(F, ln, 0, 1), mod_vec(F, ln, 0, 0), NMOD, last ? nullptr : HA,
                  kvm + D, kvm, 2 * D, (l == NA - 1) ? (bf16*)(mix + MX_HKV) : nullptr);
        } PHASE_END
    }
#undef PHASE_BEGIN
#undef PHASE_END
}

extern "C" void kernel_launch(void* const* d_in, const int* in_sizes, int n_in, void* d_out, int out_size, void* d_ws, size_t ws_size, hipStream_t stream) {
    static int grid = 0;
    if (grid == 0) {
        if (n_in != 20 || in_sizes[0] != M * D || out_size != M * D || ws_size < WS_END) { fprintf(stderr, "kernel_launch: shape/workspace mismatch: n_in %d in0 %d out %d ws %zu (need %zu)\n", n_in, n_in > 0 ? in_sizes[0] : -1, out_size, ws_size, (size_t)WS_END); grid = -1; return; }
        int dev = 0, cus = 0, per_cu = 0;
        if (hipGetDevice(&dev) != hipSuccess || hipDeviceGetAttribute(&cus, hipDeviceAttributeMultiprocessorCount, dev) != hipSuccess) { grid = -1; return; }
        if (hipFuncSetAttribute((const void*)yoco_fwd, hipFuncAttributeMaxDynamicSharedMemorySize, LDS_BYTES) != hipSuccess) { fprintf(stderr, "kernel_launch: hipFuncSetAttribute failed\n"); grid = -1; return; }
        if (hipOccupancyMaxActiveBlocksPerMultiprocessor(&per_cu, (const void*)yoco_fwd, NTHREADS, LDS_BYTES) != hipSuccess || per_cu < 1) fprintf(stderr, "kernel_launch: occupancy query reports %d\n", per_cu);
        (void)hipGetLastError();
        grid = cus;
        if (grid != 256) fprintf(stderr, "kernel_launch: %d CUs (built for 256)\n", grid);
    }
    if (grid < 0) return;
    if (hipMemsetAsync((char*)d_ws + WS_CTL, 0, CTL_ZERO_BYTES, stream) != hipSuccess) return;
    Args a{};
    for (int i = 0; i < 20; ++i) a.in[i] = (const float*)d_in[i];
    a.out = (float*)d_out; a.ws = (unsigned char*)d_ws;
#if MK_SPLIT
    for (int p = 0; p < N_PHASES; ++p) { a.ph_lo = p; a.ph_hi = p + 1; a.li = 0; hipLaunchKernelGGL(yoco_fwd, dim3(grid), dim3(NTHREADS), LDS_BYTES, stream, a); }
#else
    a.ph_lo = 0; a.ph_hi = N_PHASES; a.li = 0;
    hipLaunchKernelGGL(yoco_fwd, dim3(grid), dim3(NTHREADS), LDS_BYTES, stream, a);
#endif
    const hipError_t le = hipPeekAtLastError();
    if (le != hipSuccess) fprintf(stderr, "kernel_launch: launch failed: %s\n", hipGetErrorName(le));
}
```

```cpp
#include <hip/hip_runtime.h>
#include <cstdio>
#include <cstdint>
namespace pg8 {
#define PG8_LAS __attribute__((address_space(3)))
typedef unsigned short bf16_t;
typedef short bf16x8 __attribute__((ext_vector_type(8)));
typedef float f32x4 __attribute__((ext_vector_type(4)));
typedef unsigned u32x4 __attribute__((ext_vector_type(4)));
constexpr int BM = 256, BK = 64, HALF = 128, HTB = HALF * BK * 2  , STAGE_BYTES = 8 * HTB, NXCD = 8, WGM = 8;

__host__ __device__ __forceinline__ int lds_byte(int r, int c) { const int st = (r >> 4) * 2 + (c >> 5), rr = r & 15, cc = c & 31, ob = rr * 64 + cc * 2; return st * 1024 + (ob ^ (((ob >> 9) & 1) << 5)); }
__host__ __device__ __forceinline__ void stage_rc(int b, int& R, int& C) { const int st = b / 1024, sb = b % 1024, swz = sb ^ (((sb >> 9) & 1) << 5); R = (st >> 1) * 16 + swz / 64; C = (st & 1) * 32 + (swz % 64) / 2; }
__host__ __device__ __forceinline__ int perm32(int rho) { const int n = rho >> 4, i = rho & 15; return 8 * (i >> 2) + 4 * n + (i & 3); }

struct Unit { int pm, pn; };
struct Gemm { const bf16_t* A; const bf16_t* Bt; int M, N, K; };

struct StaticOrder {
    int nM, nN, nwg, G, c;
    __host__ __device__ void init(int M, int N, int G_, int c_) { nM = M / BM; nN = N / BM; nwg = nM * nN; G = G_; c = c_; }
    __host__ __device__ bool next(int i, Unit& u) const {
        const long L = (long)i * G + c; if (L >= nwg) return false;
        int wgid = (int)L; { const int q = nwg / NXCD, r = nwg % NXCD, xcd = wgid % NXCD, off = wgid / NXCD; wgid = (xcd < r ? xcd * (q + 1) : r * (q + 1) + (xcd - r) * q) + off; }
        const int nig = WGM * nN, gid = wgid / nig, fm = gid * WGM, gsz = (nM - fm) < WGM ? (nM - fm) : WGM;
        u.pm = fm + ((wgid % nig) % gsz); u.pn = (wgid % nig) / gsz; return true;
    }
    __device__ __forceinline__ void a_ready(const Unit&) const {}
    __device__ __forceinline__ void done(const Unit&) const {}
};

__device__ __forceinline__ unsigned cvt_pk_bf16(float lo, float hi) { unsigned r; asm volatile("v_cvt_pk_bf16_f32 %0, %1, %2" : "=v"(r) : "v"(lo), "v"(hi)); return r; }
typedef float f32x2 __attribute__((ext_vector_type(2)));

struct EpiBf16Seg {
    static constexpr bool PERM = true, AFTER_DRAIN = false;
    bf16_t* O0; bf16_t* O1; bf16_t* O2; int ld0, ld1, ld2, t1, t2; float scale0;
    __device__ __forceinline__ void operator()(const f32x4 (&acc)[2][2][4][2], const Unit& u, int wr, int wc, int fr, int fq) const {
        const int row0 = u.pm * BM + wr * 64 + fr;
        bf16_t* base; int ld, ct; float sc = 1.f;
        if (u.pn < t1) { base = O0; ld = ld0; ct = u.pn; sc = scale0; } else if (u.pn < t2) { base = O1; ld = ld1; ct = u.pn - t1; } else { base = O2; ld = ld2; ct = u.pn - t2; }
        const int col0 = ct * BM + wc * 32 + 8 * fq;
#pragma unroll
        for (int ai = 0; ai < 2; ++ai)
#pragma unroll
            for (int m = 0; m < 4; ++m) { bf16_t* rowp = base + (size_t)(row0 + ai * HALF + m * 16) * ld + col0;
#pragma unroll
                for (int bj = 0; bj < 2; ++bj) { const f32x4 v0 = acc[ai][bj][m][0] * sc, v1 = acc[ai][bj][m][1] * sc;
                    u32x4 w; w.x = cvt_pk_bf16(v0[0], v0[1]); w.y = cvt_pk_bf16(v0[2], v0[3]); w.z = cvt_pk_bf16(v1[0], v1[1]); w.w = cvt_pk_bf16(v1[2], v1[3]);
                    *(u32x4*)(rowp + bj * HALF) = w; } }
    }
};
struct EpiSqRelu {
    static constexpr bool PERM = true, AFTER_DRAIN = false;
    bf16_t* O; int ldc; const float* bias;
    __device__ __forceinline__ void operator()(const f32x4 (&acc)[2][2][4][2], const Unit& u, int wr, int wc, int fr, int fq) const {
        const int row0 = u.pm * BM + wr * 64 + fr, col0 = u.pn * BM + wc * 32 + 8 * fq;
        f32x4 bv[2][2];
#pragma unroll
        for (int bj = 0; bj < 2; ++bj)
#pragma unroll
            for (int n = 0; n < 2; ++n) bv[bj][n] = *(const f32x4*)(bias + col0 + bj * HALF + 4 * n);
#pragma unroll
        for (int ai = 0; ai < 2; ++ai)
#pragma unroll
            for (int m = 0; m < 4; ++m) { bf16_t* rowp = O + (size_t)(row0 + ai * HALF + m * 16) * ldc + col0;
#pragma unroll
                for (int bj = 0; bj < 2; ++bj) { f32x4 v0 = acc[ai][bj][m][0] + bv[bj][0], v1 = acc[ai][bj][m][1] + bv[bj][1];
                    v0 = __builtin_elementwise_max(v0, (f32x4){0.f, 0.f, 0.f, 0.f}); v1 = __builtin_elementwise_max(v1, (f32x4){0.f, 0.f, 0.f, 0.f}); v0 = v0 * v0; v1 = v1 * v1;
                    u32x4 w; w.x = cvt_pk_bf16(v0[0], v0[1]); w.y = cvt_pk_bf16(v0[2], v0[3]); w.z = cvt_pk_bf16(v1[0], v1[1]); w.w = cvt_pk_bf16(v1[2], v1[3]);
                    *(u32x4*)(rowp + bj * HALF) = w; } }
    }
};
struct EpiResid {
    static constexpr bool PERM = false, AFTER_DRAIN = false;
    const float* X; float* Tout; int ldc; const float* bias; const float* gate; int gstride, rows_per_batch; float alpha;
    __device__ __forceinline__ void operator()(const f32x4 (&acc)[2][2][4][2], const Unit& u, int wr, int wc, int fr, int fq) const {
        const int row0 = u.pm * BM + wr * 64 + fr, col0 = u.pn * BM + wc * 32 + 4 * fq;
        const float* gp = gate + (size_t)((u.pm * BM) / rows_per_batch) * gstride + col0;
        f32x4 gv[2][2], bv[2][2];
#pragma unroll
        for (int bj = 0; bj < 2; ++bj)
#pragma unroll
            for (int n = 0; n < 2; ++n) { gv[bj][n] = *(const f32x4*)(gp + bj * HALF + n * 16) + 1.0f; bv[bj][n] = bias ? *(const f32x4*)(bias + col0 + bj * HALF + n * 16) : (f32x4){0.f, 0.f, 0.f, 0.f}; }
#pragma unroll
        for (int ai = 0; ai < 2; ++ai)
#pragma unroll
            for (int m = 0; m < 4; ++m) { const size_t off = (size_t)(row0 + ai * HALF + m * 16) * ldc + col0;
#pragma unroll
                for (int bj = 0; bj < 2; ++bj)
#pragma unroll
                    for (int n = 0; n < 2; ++n) { const f32x4 xs = *(const f32x4*)(X + off + bj * HALF + n * 16);
                        *(f32x4*)(Tout + off + bj * HALF + n * 16) = xs * alpha + gv[bj][n] * (acc[ai][bj][m][n] + bv[bj][n]); }
                if (m & 1) asm volatile("" ::: "memory"); }
    }
};

template <class Epi, class Sched, bool ALIGN_EPI = false, bool SP2 = false>
__device__ __forceinline__ void gemm_phase(PG8_LAS unsigned char* lds, const Gemm g, const Sched& S, const Epi& E) {
    int tid_ = threadIdx.x; asm volatile("" : "+v"(tid_));
    const int tid = tid_, wid = __builtin_amdgcn_readfirstlane(tid >> 6), lane = tid & 63, wr = wid >> 2, wc = wid & 3, fr = lane & 15, fq = lane >> 4;
    const int K = g.K, nt = K / BK;
    unsigned voffA[2], voffB[2];
#pragma unroll
    for (int i = 0; i < 2; ++i) { int R, C; stage_rc(tid * 16 + i * 8192, R, C); const int Rb = Epi::PERM ? ((R & ~31) + perm32(R & 31)) : R;
        voffA[i] = (unsigned)(R * K + C) * 2u; voffB[i] = (unsigned)(Rb * K + C) * 2u; }
    const size_t kstep = (size_t)(BK * 2);
    const size_t hstep = (size_t)HALF * K * 2;
    const size_t tstep = 2 * hstep;
    const unsigned ldsw = (unsigned)wid * 1024u;
    const int aoff = lds_byte(wr * 64 + fr, fq * 8), boff = lds_byte(wc * 32 + fr, fq * 8);
#define PG8_SA(b, h) (((b) * 2 + (h)) * HTB)
#define PG8_SB(b, h) ((4 + (b) * 2 + (h)) * HTB)
#define PG8_STAGE(bufoff, gbase, voff) do { _Pragma("unroll") for (int _i = 0; _i < 2; ++_i) \
        __builtin_amdgcn_global_load_lds((const unsigned*)((const char*)(gbase) + (voff)[_i]), (PG8_LAS unsigned*)(lds + (bufoff) + ldsw + _i * 8192), 16, 0, 0); } while (0)
#define PG8_LDA(dst, b, h) do { _Pragma("unroll") for (int m = 0; m < 4; ++m) _Pragma("unroll") for (int k = 0; k < 2; ++k) dst[m][k] = *(const PG8_LAS bf16x8*)(lds + PG8_SA(b, h) + aoff + m * 2048 + k * 1024); } while (0)
#define PG8_LDB(dst, b, h) do { _Pragma("unroll") for (int n = 0; n < 2; ++n) _Pragma("unroll") for (int k = 0; k < 2; ++k) dst[n][k] = *(const PG8_LAS bf16x8*)(lds + PG8_SB(b, h) + boff + n * 2048 + k * 1024); } while (0)
#define PG8_MMA(ai, bj, At, Bt) do { __builtin_amdgcn_s_setprio(1); _Pragma("unroll") for (int m = 0; m < 4; ++m) _Pragma("unroll") for (int n = 0; n < 2; ++n) _Pragma("unroll") for (int k = 0; k < 2; ++k) \
        acc[ai][bj][m][n] = __builtin_amdgcn_mfma_f32_16x16x32_bf16(Bt[n][k], At[m][k], acc[ai][bj][m][n], 0, 0, 0); __builtin_amdgcn_s_setprio(0); } while (0)
#define PG8_WAIT_V(n) asm volatile("s_waitcnt vmcnt(" #n ")" ::: "memory")
#define PG8_WAIT_L(n) asm volatile("s_waitcnt lgkmcnt(" #n ")" ::: "memory")
#define PG8_BAR __builtin_amdgcn_s_barrier()
#define PG8_SCHED __builtin_amdgcn_sched_barrier(0)
    Unit cur, nxt; int ui = 0;
    if (!S.next(0, cur)) return;
    f32x4 acc[2][2][4][2];
#pragma unroll
    for (int a = 0; a < 2; ++a)
#pragma unroll
        for (int b = 0; b < 2; ++b)
#pragma unroll
            for (int m = 0; m < 4; ++m)
#pragma unroll
                for (int n = 0; n < 2; ++n) acc[a][b][m][n] = (f32x4){0.f, 0.f, 0.f, 0.f};
    bf16x8 At[4][2], B0[2][2], B1[2][2];
    const char* cA = (const char*)g.A + (size_t)cur.pm * tstep; const char* cB = (const char*)g.Bt + (size_t)cur.pn * tstep;
    S.a_ready(cur);
    if constexpr (SP2) {
        PG8_STAGE(PG8_SB(0, 0), cB, voffB); PG8_STAGE(PG8_SB(0, 1), cB + hstep, voffB); PG8_STAGE(PG8_SA(0, 0), cA, voffA); PG8_STAGE(PG8_SA(0, 1), cA + hstep, voffA);
        if (wr == 1) PG8_BAR;
        PG8_WAIT_V(2); PG8_BAR;
        PG8_STAGE(PG8_SB(1, 0), cB + kstep, voffB); PG8_STAGE(PG8_SA(1, 0), cA + kstep, voffA); PG8_STAGE(PG8_SB(1, 1), cB + hstep + kstep, voffB);
        PG8_WAIT_V(6); PG8_BAR;
    } else {
        PG8_STAGE(PG8_SB(0, 0), cB, voffB); PG8_STAGE(PG8_SA(0, 0), cA, voffA); PG8_STAGE(PG8_SB(0, 1), cB + hstep, voffB); PG8_STAGE(PG8_SA(0, 1), cA + hstep, voffA);
        if (wr == 1) PG8_BAR;
        PG8_WAIT_V(4); PG8_BAR;
        PG8_STAGE(PG8_SB(1, 0), cB + kstep, voffB); PG8_STAGE(PG8_SA(1, 0), cA + kstep, voffA); PG8_STAGE(PG8_SB(1, 1), cB + hstep + kstep, voffB);
        PG8_WAIT_V(6); PG8_BAR;
    }
    for (;;) {
        const bool has_next = S.next(ui + 1, nxt);
        const char* nA = has_next ? (const char*)g.A + (size_t)nxt.pm * tstep : cA; const char* nB = has_next ? (const char*)g.Bt + (size_t)nxt.pn * tstep : cB;
        for (int t = 0; t < nt; t += 2) {
            const bool last = (t == nt - 2);
            const char* a1 = cA + (size_t)(t + 1) * kstep;
            const char* a2 = last ? nA : cA + (size_t)(t + 2) * kstep; const char* b2 = last ? nB : cB + (size_t)(t + 2) * kstep;
            const char* a3 = a2 + kstep; const char* b3 = b2 + kstep;
            if (last && has_next) S.a_ready(nxt);
            if constexpr (SP2) {
            PG8_LDB(B0, 0, 0); PG8_LDB(B1, 0, 1); PG8_SCHED; PG8_LDA(At, 0, 0); PG8_STAGE(PG8_SA(1, 1), a1 + hstep, voffA);
            PG8_WAIT_V(8); PG8_WAIT_L(0); PG8_BAR; PG8_MMA(0, 0, At, B0); PG8_MMA(0, 1, At, B1); PG8_BAR; PG8_SCHED;
            PG8_LDA(At, 0, 1); PG8_STAGE(PG8_SB(0, 0), b2, voffB); PG8_STAGE(PG8_SB(0, 1), b2 + hstep, voffB); PG8_STAGE(PG8_SA(0, 0), a2, voffA);
            PG8_WAIT_V(8); PG8_WAIT_L(0); PG8_BAR; PG8_MMA(1, 0, At, B0); PG8_MMA(1, 1, At, B1); PG8_BAR; PG8_SCHED;
            PG8_LDB(B0, 1, 0); PG8_LDB(B1, 1, 1); PG8_SCHED; PG8_LDA(At, 1, 0); PG8_STAGE(PG8_SA(0, 1), a2 + hstep, voffA);
            PG8_WAIT_V(8); PG8_WAIT_L(0); PG8_BAR; PG8_MMA(0, 0, At, B0); PG8_MMA(0, 1, At, B1); PG8_BAR; PG8_SCHED;
            PG8_LDA(At, 1, 1); PG8_STAGE(PG8_SB(1, 0), b3, voffB); PG8_STAGE(PG8_SB(1, 1), b3 + hstep, voffB); PG8_STAGE(PG8_SA(1, 0), a3, voffA);
            PG8_WAIT_V(8); PG8_WAIT_L(0); PG8_BAR; PG8_MMA(1, 0, At, B0); PG8_MMA(1, 1, At, B1); PG8_BAR; PG8_SCHED;
            } else {
            PG8_LDB(B0, 0, 0); PG8_SCHED; PG8_LDA(At, 0, 0); PG8_STAGE(PG8_SA(1, 1), a1 + hstep, voffA);
            PG8_WAIT_L(8); PG8_BAR; PG8_WAIT_L(0); PG8_MMA(0, 0, At, B0); PG8_BAR; PG8_SCHED;
            PG8_LDB(B1, 0, 1); PG8_STAGE(PG8_SB(0, 0), b2, voffB);
            PG8_BAR; PG8_WAIT_L(0); PG8_MMA(0, 1, At, B1); PG8_BAR;
            PG8_LDA(At, 0, 1); PG8_STAGE(PG8_SA(0, 0), a2, voffA);
            PG8_BAR; PG8_WAIT_L(0); PG8_MMA(1, 0, At, B0); PG8_BAR; PG8_SCHED;
            PG8_STAGE(PG8_SB(0, 1), b2 + hstep, voffB);
            PG8_WAIT_V(6); PG8_BAR; PG8_MMA(1, 1, At, B1); PG8_BAR;
            PG8_LDB(B0, 1, 0); PG8_SCHED; PG8_LDA(At, 1, 0); PG8_STAGE(PG8_SA(0, 1), a2 + hstep, voffA);
            PG8_WAIT_L(8); PG8_BAR; PG8_WAIT_L(0); PG8_MMA(0, 0, At, B0); PG8_BAR; PG8_SCHED;
            PG8_LDB(B1, 1, 1); PG8_STAGE(PG8_SB(1, 0), b3, voffB);
            PG8_BAR; PG8_WAIT_L(0); PG8_MMA(0, 1, At, B1); PG8_BAR;
            PG8_LDA(At, 1, 1); PG8_STAGE(PG8_SA(1, 0), a3, voffA);
            PG8_BAR; PG8_WAIT_L(0); PG8_MMA(1, 0, At, B0); PG8_BAR; PG8_SCHED;
            PG8_STAGE(PG8_SB(1, 1), b3 + hstep, voffB);
            PG8_WAIT_V(6); PG8_BAR; PG8_MMA(1, 1, At, B1); PG8_BAR;
            }
        }
        if constexpr (ALIGN_EPI) { if (wr == 0) PG8_BAR; }
        if constexpr (!Epi::AFTER_DRAIN) { E(acc, cur, wr, wc, fr, fq); S.done(cur); }
        if (!has_next) break;
#pragma unroll
        for (int a = 0; a < 2; ++a)
#pragma unroll
            for (int b = 0; b < 2; ++b)
#pragma unroll
                for (int m = 0; m < 4; ++m)
#pragma unroll
                    for (int n = 0; n < 2; ++n) acc[a][b][m][n] = (f32x4){0.f, 0.f, 0.f, 0.f};
        cur = nxt; cA = nA; cB = nB; ++ui;
        if constexpr (ALIGN_EPI) { if (wr == 1) PG8_BAR; }
    }
    PG8_WAIT_V(0);
    if constexpr (!ALIGN_EPI) { if (wr == 0) PG8_BAR; }
    PG8_BAR;
    if constexpr (Epi::AFTER_DRAIN) { E.fused(acc, cur, wr, wc, fr, fq, lds, wid, lane); S.done(cur); }
#undef PG8_SA
#undef PG8_SB
#undef PG8_STAGE
#undef PG8_LDA
#undef PG8_LDB
#undef PG8_MMA
#undef PG8_WAIT_V
#undef PG8_WAIT_L
#undef PG8_BAR
#undef PG8_SCHED
}
}
#ifndef MK_SPLIT
#define MK_SPLIT 0
#endif
#ifndef NAIVE_GLA
#define NAIVE_GLA 0
#endif
#ifndef NAIVE_SB
#define NAIVE_SB 0
#endif
constexpr int NWAVES = 8, NTHREADS = 512;

constexpr int NB = 4, T = 4096, D = 2048, M = NB * T, FF = 8192, DEPTH = 4, NA = 2;
constexpr int GH = 4, GDK = 256, GDV = 512, GQK = 1024, GVD = 2048, GRANK = 16, GCH = 64, GNIN = 6160;
constexpr int SH = 16, SHD = 128;
constexpr int NMOD = 6 * D;
constexpr int NENT = DEPTH * NB * NMOD + NB * 2 * D;
constexpr int KSPLIT = 8;
constexpr float ALPHA = 1.6817928305074290f;
constexpr float LN_EPS = 1e-5f, RMS_EPS = 1e-5f, LOG2E = 1.4426950408889634f;

constexpr size_t MiB = 1u << 20;
constexpr size_t WS_CTL = 0, CTL_ZERO_BYTES = 1 * MiB;
constexpr size_t WS_MOD = 1 * MiB;
constexpr size_t WS_PART = 2 * MiB;
constexpr size_t WS_SSQ = 9 * MiB;
constexpr size_t WS_DECAY = 17 * MiB;
constexpr size_t WS_GL = 18 * MiB;
constexpr size_t WS_WIN = 20 * MiB, WIN_STRIDE = 25 * MiB;
constexpr size_t WS_WGOUT = 70 * MiB;
constexpr size_t WS_WKV = 86 * MiB;
constexpr size_t WS_WQ = 102 * MiB, WS_WSOUT = 118 * MiB;
constexpr size_t WS_W1 = 134 * MiB, WS_W2 = 262 * MiB;
constexpr size_t WS_XA = 390 * MiB, WS_TB = 518 * MiB;
constexpr size_t WS_HA = 646 * MiB, WS_OG = 710 * MiB;
constexpr size_t WS_MIX = 774 * MiB;
constexpr size_t MX_Q = 0, MX_K = 32 * MiB, MX_R = 64 * MiB, MX_VT = 128 * MiB, MX_BC = 192 * MiB, MX_QD = 256 * MiB, MX_KST = 288 * MiB, MX_SM = 320 * MiB;
constexpr size_t MX_SQ = 0, MX_SK = 64 * MiB, MX_SVT = 128 * MiB, MX_HKV = 192 * MiB;
constexpr size_t WS_U = 1166 * MiB, WS_END = 1422 * MiB;
constexpr int CW_TMO = 0, CW_BAR = 4096;

constexpr int RING_OFF = 0, RING_BYTES = 131072;
constexpr int LDSCTL_OFF = 146944, MISC_OFF = LDSCTL_OFF + 320;
constexpr int LDS_BYTES = 147456;

#define GAS __attribute__((address_space(1)))
#define LAS __attribute__((address_space(3)))
typedef unsigned short bf16;
typedef unsigned v4u __attribute__((ext_vector_type(4)));
typedef unsigned v2u __attribute__((ext_vector_type(2)));
typedef float f32x4 __attribute__((ext_vector_type(4)));
typedef short bf16x8 __attribute__((ext_vector_type(8)));
typedef GAS unsigned gu32;
#define RLX_AGENT __ATOMIC_RELAXED, __HIP_MEMORY_SCOPE_AGENT
#define LDS_WAIT() asm volatile("s_waitcnt lgkmcnt(0)" ::: "memory")
__device__ __forceinline__ unsigned f2bf(float f) { unsigned u = __builtin_bit_cast(unsigned, f); return (u + 0x7fffu + ((u >> 16) & 1u)) >> 16; }
__device__ __forceinline__ unsigned pk2(float lo, float hi) { return f2bf(lo) | (f2bf(hi) << 16); }
__device__ __forceinline__ float bf_lo(unsigned w) { return __builtin_bit_cast(float, w << 16); }
__device__ __forceinline__ float bf_hi(unsigned w) { return __builtin_bit_cast(float, w & 0xffff0000u); }
__device__ __forceinline__ float bf1(bf16 h) { return __builtin_bit_cast(float, (unsigned)h << 16); }
__device__ __forceinline__ float wave_sum(float v) {
#pragma unroll
    for (int o = 1; o < 64; o <<= 1) v += __shfl_xor(v, o);
    return v;
}
__device__ __forceinline__ float ex2(float x) { return __builtin_amdgcn_exp2f(x); }
__device__ __forceinline__ float lg2(float x) { return __builtin_amdgcn_logf(x); }
__device__ __forceinline__ float log2_sigmoid(float x) { const float z = x * LOG2E; return fminf(z, 0.f) - lg2(1.f + ex2(-fabsf(z))); }

#define XB_TMO      128
#define XB_XCNT(j)  (256  + 64 * (j))
#define XB_XSUB(j)  (1280 + 64 * (j))
#define XB_XGEN(j)  (2304 + 64 * (j))
#define XB_TOP      3328
#define XB_TOPGEN   3392
#define XCD_BAR_WORDS 3456
#define XB_SPIN_CAP (1u << 18)

__device__ __forceinline__ unsigned xb_ld(unsigned* p)              { return __hip_atomic_load(p, __ATOMIC_RELAXED, __HIP_MEMORY_SCOPE_AGENT); }
__device__ __forceinline__ unsigned xb_add(unsigned* p, unsigned v) { return __hip_atomic_fetch_add(p, v, __ATOMIC_RELAXED, __HIP_MEMORY_SCOPE_AGENT); }
__device__ __forceinline__ unsigned xb_xcc_id() { return (unsigned)__builtin_amdgcn_s_getreg((3 << 11) | 20) & 0xFu; }
#define XB_SPIN(cond, bar) do { unsigned _sp = 0; while (cond) { __builtin_amdgcn_s_sleep(1); \
    if ((++_sp & 255u) == 0u) { if (xb_ld(&(bar)[XB_TMO])) break; if (_sp > XB_SPIN_CAP) { atomicAdd(&(bar)[XB_TMO], 1u); break; } } } } while (0)

struct XcdBarrier {
    unsigned* bar; unsigned x;
    volatile LAS unsigned* st;
};

__device__ __forceinline__ XcdBarrier xcd_barrier_post(unsigned* bar, volatile LAS unsigned* st) {
    XcdBarrier b; b.bar = bar; b.x = xb_xcc_id(); b.st = st;
    if (threadIdx.x == 0) (void)xb_add(&bar[XB_XCNT(b.x)], 1u);
    return b;
}
__device__ __forceinline__ void xcd_barrier_complete(unsigned* bar, unsigned x, unsigned& nloc, unsigned& nx) {
    const unsigned G = gridDim.x * gridDim.y * gridDim.z;
    unsigned sum, cnt, mine, sp = 0u;
    for (;;) {
        sum = 0u; cnt = 0u; mine = 0u;
#pragma unroll
        for (unsigned j = 0; j < 16; ++j) { const unsigned c = xb_ld(&bar[XB_XCNT(j)]); sum += c; cnt += (c > 0u) ? 1u : 0u; mine = (j == x) ? c : mine; }
        if (sum == G) break;
        __builtin_amdgcn_s_sleep(1);
        if ((++sp & 255u) == 0u) { if (xb_ld(&bar[XB_TMO])) break; if (sp > XB_SPIN_CAP) { atomicAdd(&bar[XB_TMO], 1u); break; } }
    }
    nloc = mine > 0u ? mine : 1u; nx = cnt > 0u ? cnt : 1u;
}

__device__ __forceinline__ void xcd_barrier(const XcdBarrier& b) {
    asm volatile("s_waitcnt vmcnt(0)" ::: "memory");
    __syncthreads();
    if (threadIdx.x == 0) {
        unsigned* bar = b.bar;
        __builtin_amdgcn_s_waitcnt(0);
        unsigned nloc = b.st[0], nx = b.st[1];
        if (nloc == 0u) { xcd_barrier_complete(bar, b.x, nloc, nx); b.st[0] = nloc; b.st[1] = nx; }
        const unsigned old = xb_add(&bar[XB_XSUB(b.x)], 1u);
        const unsigned gen = old / nloc;
        if (old + 1u == (gen + 1u) * nloc) {
            __builtin_amdgcn_fence(__ATOMIC_RELEASE, "agent");
            asm volatile("s_waitcnt vmcnt(0)" ::: "memory");
            const unsigned og = xb_add(&bar[XB_TOP], 1u);
            const unsigned tg = og / nx;
            if (og + 1u == (tg + 1u) * nx) xb_add(&bar[XB_TOPGEN], 1u);
            else XB_SPIN(xb_ld(&bar[XB_TOPGEN]) == tg, bar);
            __builtin_amdgcn_fence(__ATOMIC_ACQUIRE, "agent");
            xb_add(&bar[XB_XGEN(b.x)], 1u);
            asm volatile("s_waitcnt vmcnt(0)" ::: "memory");
        } else {
            XB_SPIN(xb_ld(&bar[XB_XGEN(b.x)]) == gen, bar);
            __builtin_amdgcn_fence(__ATOMIC_ACQUIRE, "agent");
            asm volatile("s_waitcnt vmcnt(0)" ::: "memory");
        }
    }
    __syncthreads();
}
struct Args { const float* in[20]; float* out; unsigned char* ws; int ph_lo, ph_hi, li, pad; };
struct Frame {
    LAS unsigned char* lds;
    volatile LAS unsigned* MISC;
    gu32* ctl;
    int tid, lane, wave, vcu, G;
    unsigned char* ws;
};
enum { IN_X = 0, IN_C, IN_ADAW, IN_ADAB, IN_LNG, IN_LNB, IN_GWIN, IN_GWUP, IN_GBG, IN_GNG, IN_GWOUT, IN_KVADAW, IN_KVADAB, IN_WKV, IN_SWQ, IN_SWOUT, IN_W1, IN_B1, IN_W2, IN_B2 };
__device__ __forceinline__ const float* mod_vec(const Frame& F, int l, int b, int chunk) { return (const float*)(F.ws + WS_MOD) + (size_t)(l * NB + b) * NMOD + chunk * D; }

__device__ __forceinline__ void tr_item(const float* W, int ldw, int K, bf16* WT, int k0, int n0s, int nd0, LAS float* scr, int lane) {
    const int lr = lane >> 4, lc = 4 * (lane & 15);
#pragma unroll
    for (int i = 0; i < 16; ++i) { const int kk = 4 * i + lr; const f32x4 v = *(const f32x4*)(W + (size_t)(k0 + kk) * ldw + n0s + lc);
        LAS float* s = scr + kk * 65 + lc; s[0] = v[0]; s[1] = v[1]; s[2] = v[2]; s[3] = v[3]; }
    LDS_WAIT(); asm volatile("" ::: "memory");
    const int c = lane & 7;
#pragma unroll
    for (int j = 0; j < 8; ++j) { const int n = (lane >> 3) + 8 * j; const LAS float* s = scr + (8 * c) * 65 + n;
        v4u o; o.x = pk2(s[0 * 65], s[1 * 65]); o.y = pk2(s[2 * 65], s[3 * 65]); o.z = pk2(s[4 * 65], s[5 * 65]); o.w = pk2(s[6 * 65], s[7 * 65]);
        *(v4u*)(WT + (size_t)(nd0 + n) * K + k0 + 8 * c) = o; }
    LDS_WAIT(); asm volatile("" ::: "memory");
}
__device__ __forceinline__ void tr_matrix_item(const float* W, int ldw, int K, int N, bf16* WT, int item, int remap_win, LAS float* scr, int lane) {
    const int nblk = N / 64, kb = item / nblk, nb = item % nblk; int nd0 = 64 * nb;
    if (remap_win) { if (nd0 >= 2048 && nd0 < 4096) nd0 += 2048; else if (nd0 >= 4096) nd0 -= 2048; }
    tr_item(W, ldw, K, WT, 64 * kb, 64 * nb, nd0, scr, lane);
}
__device__ __forceinline__ void ph_pro0(Frame& F, const Args& a) {
    LAS float* cs = (LAS float*)(F.lds);
    for (int i = F.tid; i < NB * D; i += NTHREADS) { const float v = a.in[IN_C][i]; cs[i] = v / (1.f + __expf(-v)); }
    __syncthreads();
    const int gw = F.vcu * NWAVES + F.wave, NGW = F.G * NWAVES;
    for (int task = gw; task < 208 * KSPLIT; task += NGW) {
        const int cb = task / KSPLIT, ks = task % KSPLIT;
        const float* src; int ld, j0, ebase, estride;
        if (cb < 192) { const int l = cb / 48, jb = cb % 48; src = a.in[IN_ADAW] + (size_t)l * D * NMOD; ld = NMOD; j0 = jb * 256 + F.lane * 4; ebase = l * NB * NMOD; estride = NMOD; }
        else { const int jb = cb - 192; src = a.in[IN_KVADAW]; ld = 2 * D; j0 = jb * 256 + F.lane * 4; ebase = DEPTH * NB * NMOD; estride = 2 * D; }
        f32x4 acc[NB];
#pragma unroll
        for (int b = 0; b < NB; ++b) acc[b] = (f32x4){0.f, 0.f, 0.f, 0.f};
        const float* p = src + (size_t)(ks * 256) * ld + j0; const LAS float* cp = cs + ks * 256;
#pragma unroll 8
        for (int k = 0; k < 256; ++k) { const f32x4 w = *(const f32x4*)(p + (size_t)k * ld);
#pragma unroll
            for (int b = 0; b < NB; ++b) acc[b] += w * cp[b * D + k]; }
        float* part = (float*)(F.ws + WS_PART) + (size_t)ks * NENT + ebase + j0;
#pragma unroll
        for (int b = 0; b < NB; ++b) *(f32x4*)(part + (size_t)b * estride) = acc[b];
    }
    __syncthreads();
    LAS float* scr = (LAS float*)(F.lds + F.wave * 16640);
    constexpr int I_WIN = 32 * 96, I_SQ = 32 * 32, I_KV = 32 * 64, I_W1 = 32 * 128, I_W2 = 128 * 32;
    constexpr int NITEMS = 2 * I_WIN + 2 * I_SQ + I_KV + 2 * I_SQ + 2 * I_SQ + 4 * I_W1 + 4 * I_W2;
    for (int it = gw; it < NITEMS; it += NGW) {
        int r = it;
        if (r < 2 * I_WIN) { const int l = r / I_WIN; tr_matrix_item(a.in[IN_GWIN] + (size_t)l * D * GNIN, GNIN, D, 6144, (bf16*)(F.ws + WS_WIN + l * WIN_STRIDE), r % I_WIN, 1, scr, F.lane); continue; } r -= 2 * I_WIN;
        if (r < 2 * I_SQ) { const int l = r / I_SQ; tr_matrix_item(a.in[IN_GWOUT] + (size_t)l * D * D, D, D, D, (bf16*)(F.ws + WS_WGOUT) + (size_t)l * D * D, r % I_SQ, 0, scr, F.lane); continue; } r -= 2 * I_SQ;
        if (r < I_KV) { tr_matrix_item(a.in[IN_WKV], 2 * D, D, 2 * D, (bf16*)(F.ws + WS_WKV), r, 0, scr, F.lane); continue; } r -= I_KV;
        if (r < 2 * I_SQ) { const int l = r / I_SQ; tr_matrix_item(a.in[IN_SWQ] + (size_t)l * D * D, D, D, D, (bf16*)(F.ws + WS_WQ) + (size_t)l * D * D, r % I_SQ, 0, scr, F.lane); continue; } r -= 2 * I_SQ;
        if (r < 2 * I_SQ) { const int l = r / I_SQ; tr_matrix_item(a.in[IN_SWOUT] + (size_t)l * D * D, D, D, D, (bf16*)(F.ws + WS_WSOUT) + (size_t)l * D * D, r % I_SQ, 0, scr, F.lane); continue; } r -= 2 * I_SQ;
        if (r < 4 * I_W1) { const int l = r / I_W1; tr_matrix_item(a.in[IN_W1] + (size_t)l * D * FF, FF, D, FF, (bf16*)(F.ws + WS_W1) + (size_t)l * D * FF, r % I_W1, 0, scr, F.lane); continue; } r -= 4 * I_W1;
        { const int l = r / I_W2; tr_matrix_item(a.in[IN_W2] + (size_t)l * D * FF, D, FF, D, (bf16*)(F.ws + WS_W2) + (size_t)l * D * FF, r % I_W2, 0, scr, F.lane); }
    }
    for (int idx = blockIdx.x * NTHREADS + F.tid; idx < NA * 16 * 256; idx += F.G * NTHREADS) {
        const int l = idx / 4096, n = (idx % 4096) / 256, kc = idx % 256;
        const float* s = a.in[IN_GWIN] + (size_t)l * D * GNIN + (size_t)(8 * kc) * GNIN + 6144 + n;
        v4u o; o.x = pk2(s[0], s[GNIN]); o.y = pk2(s[2 * GNIN], s[3 * GNIN]); o.z = pk2(s[4 * GNIN], s[5 * GNIN]); o.w = pk2(s[6 * GNIN], s[7 * GNIN]);
        *(v4u*)((bf16*)(F.ws + WS_WIN + l * WIN_STRIDE) + (size_t)(6144 + n) * D + 8 * kc) = o;
    }
}

__device__ __forceinline__ float mod_entry(const Frame& F, const Args& a, int e) {
    float s = (e < DEPTH * NB * NMOD) ? a.in[IN_ADAB][(e / (NB * NMOD)) * NMOD + e % NMOD] : a.in[IN_KVADAB][(e - DEPTH * NB * NMOD) % (2 * D)];
    const float* part = (const float*)(F.ws + WS_PART) + e;
#pragma unroll
    for (int ks = 0; ks < KSPLIT; ++ks) s += part[(size_t)ks * NENT];
    return s;
}
__device__ __forceinline__ void ph_pro1(Frame& F, const Args& a) {
    float* MOD = (float*)(F.ws + WS_MOD);
    constexpr int PER = NENT / 256;
    for (int s = blockIdx.x; s < 256; s += F.G) for (int e = s * PER + F.tid; e < (s + 1) * PER; e += NTHREADS) MOD[e] = mod_entry(F, a, e);
    const int b = (blockIdx.x * 64) / T;
    LAS float* lsh = (LAS float*)F.lds; LAS float* lsc = lsh + D;
    for (int j = F.tid; j < 2 * D; j += NTHREADS) lsh[j] = mod_entry(F, a, b * NMOD + j);
    __syncthreads();
    for (int i = 0; i < 8; ++i) {
        const int m = blockIdx.x * 64 + F.wave * 8 + i;
        const f32x4* xr = (const f32x4*)(a.in[IN_X] + (size_t)m * D) + F.lane; v2u* ho = (v2u*)((bf16*)(F.ws + WS_HA) + (size_t)m * D) + F.lane;
#pragma unroll
        for (int j = 0; j < 8; ++j) { const f32x4 x = xr[64 * j]; const int c = 4 * F.lane + 256 * j;
            const f32x4 sc = *(const LAS f32x4*)(lsc + c), sh = *(const LAS f32x4*)(lsh + c); const f32x4 h = x * (sc + 1.0f) + sh;
            v2u o; o.x = pk2(h[0], h[1]); o.y = pk2(h[2], h[3]); ho[64 * j] = o; }
    }
}

__device__ __forceinline__ void ph_ln(Frame& F, const float* Tin, float* Xout, const float* g, const float* bta, const float* sc, const float* sh, int bstride, bf16* Hout,
                                      const float* sc2, const float* sh2, int bstride2, bf16* H2out) {
    const int b = (blockIdx.x * 64) / T;
    f32x4 gA[8], bA[8], hA[8], hB[8];
#pragma unroll
    for (int j = 0; j < 8; ++j) { const int c = 4 * F.lane + 256 * j; gA[j] = *(const f32x4*)(g + c); bA[j] = *(const f32x4*)(bta + c);
        if (Hout) { const f32x4 s1 = *(const f32x4*)(sc + (size_t)b * bstride + c) + 1.0f, s0 = *(const f32x4*)(sh + (size_t)b * bstride + c); hA[j] = gA[j] * s1; hB[j] = bA[j] * s1 + s0; }
        else { hA[j] = gA[j]; hB[j] = bA[j]; } }
    for (int i = 0; i < 8; ++i) {
        const int m = blockIdx.x * 64 + F.wave * 8 + i;
        const f32x4* tr = (const f32x4*)(Tin + (size_t)m * D) + F.lane;
        f32x4 v[8]; float s = 0.f;
#pragma unroll
        for (int j = 0; j < 8; ++j) { v[j] = tr[64 * j]; s += (v[j][0] + v[j][1]) + (v[j][2] + v[j][3]); }
        const float mean = wave_sum(s) * (1.f / D); float s2 = 0.f;
#pragma unroll
        for (int j = 0; j < 8; ++j) { v[j] = v[j] - mean; s2 += (v[j][0] * v[j][0] + v[j][1] * v[j][1]) + (v[j][2] * v[j][2] + v[j][3] * v[j][3]); }
        const float rstd = 1.f / sqrtf(wave_sum(s2) * (1.f / D) + LN_EPS);
        f32x4* xo = (f32x4*)(Xout + (size_t)m * D) + F.lane;
#pragma unroll
        for (int j = 0; j < 8; ++j) { v[j] = v[j] * rstd; xo[64 * j] = v[j] * gA[j] + bA[j]; }
        if (Hout) { v2u* ho = (v2u*)(Hout + (size_t)m * D) + F.lane;
#pragma unroll
            for (int j = 0; j < 8; ++j) { const f32x4 h = v[j] * hA[j] + hB[j]; v2u o; o.x = pk2(h[0], h[1]); o.y = pk2(h[2], h[3]); ho[64 * j] = o; } }
        if (H2out) { v2u* ho = (v2u*)(H2out + (size_t)m * D) + F.lane;
#pragma unroll
            for (int j = 0; j < 8; ++j) { const int c = 4 * F.lane + 256 * j; const f32x4 x = v[j] * gA[j] + bA[j];
                const f32x4 h = x * (*(const f32x4*)(sc2 + (size_t)b * bstride2 + c) + 1.0f) + *(const f32x4*)(sh2 + (size_t)b * bstride2 + c);
                v2u o; o.x = pk2(h[0], h[1]); o.y = pk2(h[2], h[3]); ho[64 * j] = o; } }
    }
}

template <class Epi> __device__ __forceinline__ void run_gemm(Frame& F, const bf16* A, const bf16* Bt, int M_, int N_, int K_, const Epi& E) {
    pg8::Gemm g{A, Bt, M_, N_, K_}; pg8::StaticOrder S; S.init(M_, N_, F.G, (int)blockIdx.x);
    pg8::gemm_phase<Epi, pg8::StaticOrder, true, true>(F.lds + RING_OFF, g, S, E);
}

__device__ __forceinline__ void ph_normgate(Frame& F, const float* O, const float* SSQ, const bf16* R, const float* ng, bf16* OG) {
    f32x4 gv[8];
#pragma unroll
    for (int j = 0; j < 8; ++j) gv[j] = *(const f32x4*)(ng + (4 * F.lane + 256 * j) % GDV);
    for (int i = 0; i < 8; ++i) {
        const int m = blockIdx.x * 64 + F.wave * 8 + i;
        float q0 = SSQ[(size_t)m * 128 + F.lane], q1 = SSQ[(size_t)m * 128 + 64 + F.lane];
#pragma unroll
        for (int o = 1; o < 32; o <<= 1) { q0 += __shfl_xor(q0, o); q1 += __shfl_xor(q1, o); }
        float rs[4]; rs[0] = __shfl(q0, 0); rs[1] = __shfl(q0, 32); rs[2] = __shfl(q1, 0); rs[3] = __shfl(q1, 32);
#pragma unroll
        for (int h = 0; h < 4; ++h) rs[h] = 1.f / sqrtf(rs[h] * (1.f / GDV) + RMS_EPS);
        const f32x4* orow = (const f32x4*)(O + (size_t)m * D) + F.lane; const v2u* rrow = (const v2u*)(R + (size_t)m * D) + F.lane; v2u* og = (v2u*)(OG + (size_t)m * D) + F.lane;
#pragma unroll
        for (int j = 0; j < 8; ++j) { const f32x4 o = orow[64 * j]; const v2u rw = rrow[64 * j]; const float sc = rs[j >> 1];
            float r[4] = {bf_lo(rw.x), bf_hi(rw.x), bf_lo(rw.y), bf_hi(rw.y)}; float y[4];
#pragma unroll
            for (int q = 0; q < 4; ++q) y[q] = o[q] * sc * gv[j][q] * (r[q] / (1.f + __expf(-r[q])));
            v2u w; w.x = pk2(y[0], y[1]); w.y = pk2(y[2], y[3]); og[64 * j] = w; }
    }
}

#if NAIVE_GLA
__device__ __forceinline__ void ph_naive_gl(Frame& F, const bf16* HA, const bf16* Wgl, float* GL) {
    for (int i = 0; i < 8; ++i) {
        const int m = blockIdx.x * 64 + F.wave * 8 + i;
        v4u hv[4];
#pragma unroll
        for (int q = 0; q < 4; ++q) hv[q] = *(const v4u*)(HA + (size_t)m * D + F.lane * 8 + 512 * q);
        float mine = 0.f;
#pragma unroll 1
        for (int j = 0; j < 16; ++j) { float acc = 0.f;
#pragma unroll
            for (int q = 0; q < 4; ++q) { const v4u wv = *(const v4u*)(Wgl + (size_t)j * D + F.lane * 8 + 512 * q); const v4u h = hv[q];
                acc += bf_lo(h.x) * bf_lo(wv.x) + bf_hi(h.x) * bf_hi(wv.x) + bf_lo(h.y) * bf_lo(wv.y) + bf_hi(h.y) * bf_hi(wv.y) + bf_lo(h.z) * bf_lo(wv.z) + bf_hi(h.z) * bf_hi(wv.z) + bf_lo(h.w) * bf_lo(wv.w) + bf_hi(h.w) * bf_hi(wv.w); }
            acc = wave_sum(acc); if (F.lane == j) mine = acc; }
        if (F.lane < 16) GL[(size_t)m * 16 + F.lane] = mine;
    }
}
__device__ __forceinline__ void ph_naive_gla(Frame& F, const Args& a, int l, const bf16* Q, const bf16* Kk, const bf16* VT, const float* GL, float* O, float* SSQ) {
    const int blk = blockIdx.x, b = blk / 64, h = (blk / 16) % 4, eg = blk % 16, d = F.tid & 255, eh = F.tid >> 8;
    LAS float* P = (LAS float*)F.lds;
    LAS bf16* vbuf = (LAS bf16*)(F.lds + 36864);
    LAS float* osq = (LAS float*)(F.lds + 36864 + 4096);
    float wup[16];
#pragma unroll
    for (int j = 0; j < 16; ++j) wup[j] = a.in[IN_GWUP][(size_t)l * GRANK * GQK + j * GQK + h * GDK + d];
    const float bg = a.in[IN_GBG][l * GQK + h * GDK + d];
    float S[16];
#pragma unroll
    for (int i = 0; i < 16; ++i) S[i] = 0.f;
    for (int t0 = 0; t0 < T; t0 += 64) {
        __syncthreads();
        if (F.tid < 256) { const int row = F.tid >> 3, piece = F.tid & 7;
            *(LAS v4u*)(vbuf + row * 64 + piece * 8) = *(const v4u*)(VT + (size_t)(h * GDV + eg * 32 + row) * M + (size_t)b * T + t0 + piece * 8); }
        __syncthreads();
        for (int tt = 0; tt < 64; ++tt) {
            const int m = b * T + t0 + tt;
            float x = bg;
#pragma unroll
            for (int j = 0; j < 16; ++j) x += GL[(size_t)m * 16 + j] * wup[j];
            const float aa = ex2(log2_sigmoid(x) * (1.f / 16.f));
            const float kd = bf1(Kk[(size_t)m * GQK + h * GDK + d]), qd = bf1(Q[(size_t)m * GQK + h * GDK + d]) * 0.0625f;
#pragma unroll
            for (int i = 0; i < 16; ++i) { S[i] = aa * S[i] + kd * bf1(vbuf[(eh * 16 + i) * 64 + tt]); P[(eh * 16 + i) * 257 + d] = qd * S[i]; }
            __syncthreads();
            { const int e = F.tid >> 4, part = F.tid & 15; float s = 0.f;
#pragma unroll
                for (int k = 0; k < 16; ++k) s += P[e * 257 + part * 16 + k];
                s += __shfl_xor(s, 1); s += __shfl_xor(s, 2); s += __shfl_xor(s, 4); s += __shfl_xor(s, 8);
                if (part == 0) { O[(size_t)m * D + h * GDV + eg * 32 + e] = s; osq[e] = s * s; } }
            __syncthreads();
            if (F.tid < 2) { float q = 0.f;
#pragma unroll
                for (int k = 0; k < 16; ++k) q += osq[F.tid * 16 + k];
                SSQ[(size_t)m * 128 + h * 32 + eg * 2 + F.tid] = q; }
        }
    }
}
#endif

#if NAIVE_SB
__device__ __forceinline__ void ph_naive_sb(Frame& F, const bf16* Q, const bf16* Kk, const bf16* VT, bf16* OG) {
    const int gw = blockIdx.x * NWAVES + F.wave, NGW = F.G * NWAVES;
    for (int row = gw; row < NB * SH * T; row += NGW) {
        const int t = row % T, h = (row / T) % SH, b = row / (T * SH);
        const size_t mq = (size_t)b * T + t;
        const unsigned qw = *(const unsigned*)(Q + mq * D + h * SHD + 2 * F.lane); const float q0 = bf_lo(qw), q1 = bf_hi(qw);
        const bf16* vt0 = VT + (size_t)(h * SHD + 2 * F.lane) * M + (size_t)b * T;
        float acc0 = 0.f, acc1 = 0.f, carry = 0.f;
        for (int s0 = t - 1; s0 >= 0 && carry > -170.f; s0 -= 8) {
#pragma unroll
            for (int u = 0; u < 8; ++u) { const int s = s0 - u; if (s >= 0) {
                const unsigned kw = *(const unsigned*)(Kk + ((size_t)b * T + s) * D + h * SHD + 2 * F.lane);
                const float z = wave_sum(q0 * bf_lo(kw) + q1 * bf_hi(kw));
                const float L = lg2(1.f + ex2(-fabsf(z))), lb = fminf(z, 0.f) - L, ln = fminf(-z, 0.f) - L;
                const float aw = ex2(lb + carry); carry += ln;
                acc0 += aw * bf1(vt0[s]); acc1 += aw * bf1(vt0[M + s]); } }
        }
        *(unsigned*)(OG + mq * D + h * SHD + 2 * F.lane) = pk2(acc0, acc1);
    }
}
#endif
typedef float f32x16 __attribute__((ext_vector_type(16)));
__device__ __forceinline__ bf16x8 as_bf16x8(v4u v) { return __builtin_bit_cast(bf16x8, v); }
__device__ __forceinline__ unsigned cvtpk(float lo, float hi) { unsigned r; asm volatile("v_cvt_pk_bf16_f32 %0, %1, %2" : "=v"(r) : "v"(lo), "v"(hi)); return r; }

#if !NAIVE_GLA
__device__ __forceinline__ void ph_gate(Frame& F, const Args& a, int l, const bf16* HA, const bf16* Wgl, float* BC, float* DECAY) {
    const int m0 = blockIdx.x * 64, lane = F.lane, fr = lane & 15, fq = lane >> 4, tt = F.wave & 3, kh = F.wave >> 2;
    LAS float* gls = (LAS float*)F.lds;
    {
        f32x4 acc = (f32x4){0.f, 0.f, 0.f, 0.f};
        const bf16* ap = HA + (size_t)(m0 + 16 * tt + fr) * D + 1024 * kh + 8 * fq; const bf16* bp = Wgl + (size_t)fr * D + 1024 * kh + 8 * fq;
#pragma unroll 8
        for (int s = 0; s < 32; ++s) acc = __builtin_amdgcn_mfma_f32_16x16x32_bf16(as_bf16x8(*(const v4u*)(ap + 32 * s)), as_bf16x8(*(const v4u*)(bp + 32 * s)), acc, 0, 0, 0);
#pragma unroll
        for (int i = 0; i < 4; ++i) gls[kh * 1024 + (16 * tt + 4 * fq + i) * 16 + fr] = acc[i];
    }
    __syncthreads();
    if (F.tid < 256) { const f32x4 v = *(const LAS f32x4*)(gls + 4 * F.tid) + *(const LAS f32x4*)(gls + 1024 + 4 * F.tid); *(LAS f32x4*)(gls + 4 * F.tid) = v; }
    __syncthreads();
#pragma unroll 1
    for (int cc = 0; cc < 2; ++cc) {
        const int c = F.tid + 512 * cc;
        float wup[16];
#pragma unroll
        for (int j = 0; j < 16; ++j) wup[j] = a.in[IN_GWUP][(size_t)l * GRANK * GQK + j * GQK + c];
        const float bg = a.in[IN_GBG][l * GQK + c];
        float run = 0.f;
#pragma unroll 4
        for (int t = 0; t < 64; ++t) {
            float x = bg;
#pragma unroll
            for (int q = 0; q < 4; ++q) { const f32x4 g = *(const LAS f32x4*)(gls + t * 16 + 4 * q); x += g[0] * wup[4 * q] + g[1] * wup[4 * q + 1] + g[2] * wup[4 * q + 2] + g[3] * wup[4 * q + 3]; }
            run += log2_sigmoid(x) * (1.f / 16.f);
            BC[(size_t)(m0 + t) * GQK + c] = run;
        }
        DECAY[(size_t)blockIdx.x * GQK + c] = ex2(run);
    }
}

__device__ __forceinline__ void ph_prep(Frame& F, const bf16* Q, const bf16* Kk, const float* BC, bf16* QD, bf16* KST, bf16* SM) {
    const int lane = F.lane, r32 = lane & 31, hi = lane >> 5;
    const int gw = blockIdx.x * NWAVES + F.wave, NGW = F.G * NWAVES;
    for (int task = gw; task < (M / 64) * GH * 2; task += NGW) {
        const int unit = task >> 1, th = task & 1, cidx = unit >> 2, h = unit & 3, m0 = cidx * 64, cb = h * GDK;
        const int t = 32 * th + r32;
        f32x16 s0 = {}, s1 = {};
        const size_t rowt = (size_t)(m0 + t) * GQK + cb, rowl = (size_t)(m0 + 63) * GQK + cb, row0 = (size_t)(m0 + r32) * GQK + cb;
        bf16* kst = KST + (size_t)unit * GDK * 64;
#pragma unroll 2
        for (int s = 0; s < 16; ++s) {
            const int d8 = 16 * s + 8 * hi;
            const v4u qv = *(const v4u*)(Q + rowt + d8), kv = *(const v4u*)(Kk + rowt + d8);
            const f32x4 b0 = *(const f32x4*)(BC + rowt + d8), b1 = *(const f32x4*)(BC + rowt + d8 + 4), l0 = *(const f32x4*)(BC + rowl + d8), l1 = *(const f32x4*)(BC + rowl + d8 + 4);
            const float qf[8] = {bf_lo(qv.x), bf_hi(qv.x), bf_lo(qv.y), bf_hi(qv.y), bf_lo(qv.z), bf_hi(qv.z), bf_lo(qv.w), bf_hi(qv.w)};
            const float kf[8] = {bf_lo(kv.x), bf_hi(kv.x), bf_lo(kv.y), bf_hi(kv.y), bf_lo(kv.z), bf_hi(kv.z), bf_lo(kv.w), bf_hi(kv.w)};
            const float bc[8] = {b0[0], b0[1], b0[2], b0[3], b1[0], b1[1], b1[2], b1[3]}, bl[8] = {l0[0], l0[1], l0[2], l0[3], l1[0], l1[1], l1[2], l1[3]};
            float qd[8], ki[8], ks[8];
#pragma unroll
            for (int i = 0; i < 8; ++i) { qd[i] = qf[i] * 0.0625f * ex2(bc[i]); ki[i] = kf[i] * ex2(-bc[i]); ks[i] = kf[i] * ex2(bl[i] - bc[i]); }
            v4u qdp, kip; qdp.x = cvtpk(qd[0], qd[1]); qdp.y = cvtpk(qd[2], qd[3]); qdp.z = cvtpk(qd[4], qd[5]); qdp.w = cvtpk(qd[6], qd[7]);
            kip.x = cvtpk(ki[0], ki[1]); kip.y = cvtpk(ki[2], ki[3]); kip.z = cvtpk(ki[4], ki[5]); kip.w = cvtpk(ki[6], ki[7]);
            *(v4u*)(QD + rowt + d8) = qdp;
#pragma unroll
            for (int i = 0; i < 8; ++i) kst[(size_t)(d8 + i) * 64 + t] = (bf16)f2bf(ks[i]);
            if (th == 0) { s0 = __builtin_amdgcn_mfma_f32_32x32x16_bf16(as_bf16x8(kip), as_bf16x8(qdp), s0, 0, 0, 0); }
            else {
                const v4u k0 = *(const v4u*)(Kk + row0 + d8); const f32x4 c0 = *(const f32x4*)(BC + row0 + d8), c1 = *(const f32x4*)(BC + row0 + d8 + 4);
                v4u k0p; k0p.x = cvtpk(bf_lo(k0.x) * ex2(-c0[0]), bf_hi(k0.x) * ex2(-c0[1])); k0p.y = cvtpk(bf_lo(k0.y) * ex2(-c0[2]), bf_hi(k0.y) * ex2(-c0[3]));
                k0p.z = cvtpk(bf_lo(k0.z) * ex2(-c1[0]), bf_hi(k0.z) * ex2(-c1[1])); k0p.w = cvtpk(bf_lo(k0.w) * ex2(-c1[2]), bf_hi(k0.w) * ex2(-c1[3]));
                s0 = __builtin_amdgcn_mfma_f32_32x32x16_bf16(as_bf16x8(k0p), as_bf16x8(qdp), s0, 0, 0, 0);
                s1 = __builtin_amdgcn_mfma_f32_32x32x16_bf16(as_bf16x8(kip), as_bf16x8(qdp), s1, 0, 0, 0);
            }
        }
        bf16* smrow = SM + ((size_t)unit * 64 + t) * 64;
#pragma unroll
        for (int g = 0; g < 4; ++g) {
            const int sb = 8 * g + 4 * hi;
            float v0[4], v1[4];
#pragma unroll
            for (int i = 0; i < 4; ++i) { v0[i] = (sb + i <= t) ? s0[4 * g + i] : 0.f; v1[i] = (th == 1 && 32 + sb + i <= t) ? s1[4 * g + i] : 0.f; }
            v2u w0, w1; w0.x = cvtpk(v0[0], v0[1]); w0.y = cvtpk(v0[2], v0[3]); w1.x = cvtpk(v1[0], v1[1]); w1.y = cvtpk(v1[2], v1[3]);
            *(v2u*)(smrow + sb) = w0; *(v2u*)(smrow + 32 + sb) = w1;
        }
    }
}

__device__ __forceinline__ void ph_scan(Frame& F, const bf16* QD, const bf16* KST, const bf16* SM, const bf16* VT, const float* DECAY, float* O, float* SSQ) {
    if (F.wave >= 2) return;
    const int blk = blockIdx.x, b = blk / 64, h = (blk / 16) % 4, es = blk % 16, w = F.wave, lane = F.lane, fr = lane & 15, fq = lane >> 4;
    const int e0 = h * GDV + es * 32 + 16 * w;
    f32x4 St[16];
#pragma unroll
    for (int kt = 0; kt < 16; ++kt) St[kt] = (f32x4){0.f, 0.f, 0.f, 0.f};
    const bf16* vrow = VT + (size_t)(e0 + fr) * M + (size_t)b * T + 8 * fq;
    const int dk_lo = 8 * (fr >> 2) + (fr & 3);
#pragma unroll 1
    for (int n = 0; n < T / 64; ++n) {
        const int cidx = b * (T / 64) + n, unit = cidx * GH + h, m0 = cidx * 64;
        const bf16* smb = SM + (size_t)unit * 4096; const bf16* kstb = KST + (size_t)unit * GDK * 64; const bf16* qdb = QD + (size_t)m0 * GQK + h * GDK;
        const float* dec = DECAY + (size_t)cidx * GQK + h * GDK;
        const v4u vt0 = *(const v4u*)(vrow + n * 64), vt1 = *(const v4u*)(vrow + n * 64 + 32);
        f32x4 o[4];
#pragma unroll
        for (int tt = 0; tt < 4; ++tt) o[tt] = (f32x4){0.f, 0.f, 0.f, 0.f};
#pragma unroll
        for (int p = 0; p < 8; ++p) {
            v4u sa; sa.x = cvtpk(St[2 * p][0], St[2 * p][1]); sa.y = cvtpk(St[2 * p][2], St[2 * p][3]); sa.z = cvtpk(St[2 * p + 1][0], St[2 * p + 1][1]); sa.w = cvtpk(St[2 * p + 1][2], St[2 * p + 1][3]);
#pragma unroll
            for (int tt = 0; tt < 4; ++tt) { const v4u qb = *(const v4u*)(qdb + (size_t)(16 * tt + fr) * GQK + 32 * p + 8 * fq);
                o[tt] = __builtin_amdgcn_mfma_f32_16x16x32_bf16(as_bf16x8(sa), as_bf16x8(qb), o[tt], 0, 0, 0); }
        }
#pragma unroll
        for (int tt = 0; tt < 4; ++tt) { const v4u m0v = *(const v4u*)(smb + (16 * tt + fr) * 64 + 8 * fq), m1v = *(const v4u*)(smb + (16 * tt + fr) * 64 + 32 + 8 * fq);
            o[tt] = __builtin_amdgcn_mfma_f32_16x16x32_bf16(as_bf16x8(vt0), as_bf16x8(m0v), o[tt], 0, 0, 0);
            o[tt] = __builtin_amdgcn_mfma_f32_16x16x32_bf16(as_bf16x8(vt1), as_bf16x8(m1v), o[tt], 0, 0, 0); }
#pragma unroll
        for (int tt = 0; tt < 4; ++tt) { const int m = m0 + 16 * tt + fr;
            *(f32x4*)(O + (size_t)m * D + e0 + 4 * fq) = o[tt];
            float q = (o[tt][0] * o[tt][0] + o[tt][1] * o[tt][1]) + (o[tt][2] * o[tt][2] + o[tt][3] * o[tt][3]);
            q += __shfl_xor(q, 16); q += __shfl_xor(q, 32);
            if (fq == 0) SSQ[(size_t)m * 128 + h * 32 + es * 2 + w] = q; }
#pragma unroll
        for (int kt = 0; kt < 16; ++kt) {
            const int dkb = 32 * (kt >> 1) + 4 * (kt & 1);
            const f32x4 dv = *(const f32x4*)(dec + dkb + 8 * fq);
            const v4u ka0 = *(const v4u*)(kstb + (size_t)(dkb + dk_lo) * 64 + 8 * fq), ka1 = *(const v4u*)(kstb + (size_t)(dkb + dk_lo) * 64 + 32 + 8 * fq);
            f32x4 s = St[kt] * dv;
            s = __builtin_amdgcn_mfma_f32_16x16x32_bf16(as_bf16x8(ka0), as_bf16x8(vt0), s, 0, 0, 0);
            s = __builtin_amdgcn_mfma_f32_16x16x32_bf16(as_bf16x8(ka1), as_bf16x8(vt1), s, 0, 0, 0);
            St[kt] = s;
        }
    }
}
#endif

#if !NAIVE_SB
__device__ __forceinline__ void ph_sb(Frame& F, const bf16* Q, const bf16* Kk, const bf16* VT, bf16* OG) {
    const int lane = F.lane, r32 = lane & 31, hi = lane >> 5;
    const int gw = blockIdx.x * NWAVES + F.wave, NGW = F.G * NWAVES;
    const int keyrow = 16 * ((r32 >> 2) & 1) + (r32 & 3) + 4 * (r32 >> 3);
#pragma unroll 1
    for (int item = gw; item < NB * SH * (T / 32); item += NGW) {
        const int qb = item % (T / 32), bh = item / (T / 32), h = bh % SH, b = bh / SH;
        const size_t mb = (size_t)b * T; const int t = 32 * qb + r32;
        bf16x8 qf[8];
#pragma unroll
        for (int s = 0; s < 8; ++s) qf[s] = as_bf16x8(*(const v4u*)(Q + (mb + t) * D + h * SHD + 16 * s + 8 * hi));
        f32x16 o[4];
#pragma unroll
        for (int dt = 0; dt < 4; ++dt) o[dt] = f32x16{};
        float cprod = 1.f;
#pragma unroll 1
        for (int jt = qb; jt >= 0; --jt) {
            const int kb = 32 * jt;
            const bf16* kp = Kk + (mb + kb + keyrow) * D + h * SHD + 8 * hi;
            f32x16 z = f32x16{};
#pragma unroll
            for (int s = 0; s < 8; ++s) z = __builtin_amdgcn_mfma_f32_32x32x16_bf16(as_bf16x8(*(const v4u*)(kp + 16 * s)), qf[s], z, 0, 0, 0);
            v4u vf[4][2];
#pragma unroll
            for (int dt = 0; dt < 4; ++dt)
#pragma unroll
                for (int ks = 0; ks < 2; ++ks) vf[dt][ks] = *(const v4u*)(VT + (size_t)(h * SHD + 32 * dt + r32) * M + mb + kb + 16 * hi + 8 * ks);
            float wv[16]; float run = 1.f;
#pragma unroll
            for (int r = 15; r >= 0; --r) {
                const float zz = z[r], e = ex2(-fabsf(zz)), rc = __builtin_amdgcn_rcpf(1.f + e), er = e * rc;
                float beta = zz >= 0.f ? rc : er, omb = zz >= 0.f ? er : rc;
                if (jt == qb && 16 * hi + r >= r32) { beta = 0.f; omb = 1.f; }
                wv[r] = beta * run; run *= omb;
            }
            const float other = __shfl_xor(run, 32);
            const float fac = cprod * (hi == 0 ? other : 1.f);
            cprod *= run * other;
            v4u pb[2];
#pragma unroll
            for (int ks = 0; ks < 2; ++ks) { pb[ks].x = cvtpk(wv[8 * ks] * fac, wv[8 * ks + 1] * fac); pb[ks].y = cvtpk(wv[8 * ks + 2] * fac, wv[8 * ks + 3] * fac);
                pb[ks].z = cvtpk(wv[8 * ks + 4] * fac, wv[8 * ks + 5] * fac); pb[ks].w = cvtpk(wv[8 * ks + 6] * fac, wv[8 * ks + 7] * fac); }
#pragma unroll
            for (int dt = 0; dt < 4; ++dt)
#pragma unroll
                for (int ks = 0; ks < 2; ++ks) o[dt] = __builtin_amdgcn_mfma_f32_32x32x16_bf16(as_bf16x8(vf[dt][ks]), as_bf16x8(pb[ks]), o[dt], 0, 0, 0);
            if (__builtin_amdgcn_ballot_w64(cprod != 0.f) == 0ull) break;
        }
        bf16* orow = OG + (mb + t) * D + h * SHD;
#pragma unroll
        for (int dt = 0; dt < 4; ++dt)
#pragma unroll
            for (int g = 0; g < 4; ++g) { v2u w; w.x = cvtpk(o[dt][4 * g], o[dt][4 * g + 1]); w.y = cvtpk(o[dt][4 * g + 2], o[dt][4 * g + 3]); *(v2u*)(orow + 32 * dt + 8 * g + 4 * hi) = w; }
    }
}
#endif
#ifndef PHMASK
#define PHMASK 0xFFFFFFFFu
#endif
#define ON(k) (((PHMASK) >> (k)) & 1u)
constexpr int N_PHASES = 2 + NA * ((NAIVE_GLA ? 4 : 4) + 5) + (DEPTH - NA) * (2 + 5);
__global__ void __launch_bounds__(NTHREADS, 2) yoco_fwd(Args args) {
    extern __shared__ __attribute__((aligned(16))) unsigned char lds[];
    Frame F;
    F.lds = (LAS unsigned char*)lds;
    F.MISC = (volatile LAS unsigned*)(F.lds + MISC_OFF);
    F.tid = threadIdx.x; F.lane = F.tid & 63; F.wave = __builtin_amdgcn_readfirstlane(F.tid >> 6);
    F.G = gridDim.x; { const int bx = blockIdx.x; F.vcu = (F.G % 8 == 0) ? (bx % 8) * (F.G / 8) + bx / 8 : bx; }
    F.ws = args.ws; F.ctl = (gu32*)(args.ws + WS_CTL);
    for (int u = F.tid; u < (LDS_BYTES - LDSCTL_OFF) / 4; u += NTHREADS) ((LAS unsigned*)(F.lds + LDSCTL_OFF))[u] = 0u;
    __syncthreads();
    const int lo = args.ph_lo, hi = args.ph_hi;
    XcdBarrier bar; bar.bar = (unsigned*)(F.ctl + CW_BAR) + args.li * XCD_BAR_WORDS; bar.x = 0; bar.st = nullptr;
    if (hi - lo > 1) bar = xcd_barrier_post((unsigned*)(F.ctl + CW_BAR) + args.li * XCD_BAR_WORDS, F.MISC + 8);
    int pc = 0;
#define PHASE_BEGIN if (pc >= lo && pc < hi) { { int t_ = threadIdx.x; asm volatile("" : "+v"(t_)); F.tid = t_; F.lane = t_ & 63; }
#define PHASE_END   if (pc + 1 < hi) xcd_barrier(bar); } ++pc;

    unsigned char* ws = args.ws;
    float* XA = (float*)(ws + WS_XA); float* TB = (float*)(ws + WS_TB);
    bf16* HA = (bf16*)(ws + WS_HA); bf16* OG = (bf16*)(ws + WS_OG); bf16* U = (bf16*)(ws + WS_U);
    unsigned char* mix = ws + WS_MIX;

    PHASE_BEGIN if constexpr (ON(0)) ph_pro0(F, args); PHASE_END
    PHASE_BEGIN if constexpr (ON(1)) ph_pro1(F, args); PHASE_END

    for (int l = 0; l < DEPTH; ++l) {
        const float* xcur = (l == 0) ? args.in[IN_X] : XA;
        const bf16* wout_t;
        if (l < NA) {
            bf16* win_t = (bf16*)(ws + WS_WIN + (size_t)l * WIN_STRIDE);
            bf16* Q = (bf16*)(mix + MX_Q); bf16* Kk = (bf16*)(mix + MX_K); bf16* R = (bf16*)(mix + MX_R); bf16* VT = (bf16*)(mix + MX_VT);
            float* SSQ = (float*)(ws + WS_SSQ);
            PHASE_BEGIN
                if constexpr (ON(2)) { pg8::EpiBf16Seg E{Q, Kk, R, GQK, GQK, GVD, 4, 8, 1.0f}; run_gemm(F, HA, win_t, M, 4096, D, E); }
                if constexpr (ON(2)) { pg8::EpiBf16Seg E{VT, VT, VT, M, M, M, 1 << 20, 1 << 20, 1.0f}; run_gemm(F, win_t + (size_t)4096 * D, HA, GVD, M, D, E); }
#if NAIVE_GLA
                if constexpr (ON(3)) ph_naive_gl(F, HA, win_t + (size_t)6144 * D, (float*)(ws + WS_GL));
#else
                if constexpr (ON(3)) ph_gate(F, args, l, HA, win_t + (size_t)6144 * D, (float*)(mix + MX_BC), (float*)(ws + WS_DECAY));
#endif
            PHASE_END
#if NAIVE_GLA
            PHASE_BEGIN if constexpr (ON(4)) ph_naive_gla(F, args, l, Q, Kk, VT, (const float*)(ws + WS_GL), TB, SSQ); PHASE_END
            PHASE_BEGIN PHASE_END
#else
            PHASE_BEGIN if constexpr (ON(4)) ph_prep(F, Q, Kk, (const float*)(mix + MX_BC), (bf16*)(mix + MX_QD), (bf16*)(mix + MX_KST), (bf16*)(mix + MX_SM)); PHASE_END
            PHASE_BEGIN if constexpr (ON(13)) ph_scan(F, (const bf16*)(mix + MX_QD), (const bf16*)(mix + MX_KST), (const bf16*)(mix + MX_SM), VT, (const float*)(ws + WS_DECAY), TB, SSQ); PHASE_END
#endif
            PHASE_BEGIN if constexpr (ON(5)) ph_normgate(F, TB, SSQ, R, args.in[IN_GNG] + l * GDV, OG); PHASE_END
            wout_t = (const bf16*)(ws + WS_WGOUT) + (size_t)l * D * D;
        } else {
            const int j = l - NA;
            bf16* SQ = (bf16*)(mix + MX_SQ); bf16* SK = (bf16*)(mix + MX_SK); bf16* SVT = (bf16*)(mix + MX_SVT); bf16* HKV = (bf16*)(mix + MX_HKV);
            PHASE_BEGIN if constexpr (ON(6)) {
                const int ncall = (j == 0) ? 3 : 1;
                for (int c = 0; c < ncall; ++c) {
                    const bf16* A_ = (c == 0) ? HA : (c == 1) ? HKV : (const bf16*)(ws + WS_WKV) + (size_t)D * D;
                    const bf16* B_ = (c == 0) ? (const bf16*)(ws + WS_WQ) + (size_t)j * D * D : (c == 1) ? (const bf16*)(ws + WS_WKV) : HKV;
                    bf16* O_ = (c == 0) ? SQ : (c == 1) ? SK : SVT;
                    const int M_ = (c == 2) ? D : M, N_ = (c == 2) ? M : D;
                    pg8::EpiBf16Seg E{O_, O_, O_, N_, N_, N_, 1 << 20, 1 << 20, (c == 0) ? LOG2E * 0.08838834764831845f : 1.0f}; run_gemm(F, A_, B_, M_, N_, D, E);
                } }
            PHASE_END
#if NAIVE_SB
            PHASE_BEGIN if constexpr (ON(7)) ph_naive_sb(F, SQ, SK, SVT, OG); PHASE_END
#else
            PHASE_BEGIN if constexpr (ON(7)) ph_sb(F, SQ, SK, SVT, OG); PHASE_END
#endif
            wout_t = (const bf16*)(ws + WS_WSOUT) + (size_t)j * D * D;
        }
        PHASE_BEGIN if constexpr (ON(8)) { pg8::EpiResid E{xcur, TB, D, nullptr, mod_vec(F, l, 0, 2), NMOD, T, ALPHA}; run_gemm(F, OG, wout_t, M, D, D, E); } PHASE_END
        PHASE_BEGIN if constexpr (ON(9)) ph_ln(F, TB, XA, args.in[IN_LNG] + (size_t)(l * 2 + 0) * D, args.in[IN_LNB] + (size_t)(l * 2 + 0) * D, mod_vec(F, l, 0, 4), mod_vec(F, l, 0, 3), NMOD, HA, nullptr, nullptr, 0, nullptr); PHASE_END
        PHASE_BEGIN if constexpr (ON(10)) { pg8::EpiSqRelu E{U, FF, args.in[IN_B1] + (size_t)l * FF}; run_gemm(F, HA, (const bf16*)(ws + WS_W1) + (size_t)l * D * FF, M, FF, D, E); } PHASE_END
        PHASE_BEGIN if constexpr (ON(11)) { pg8::EpiResid E{XA, TB, D, args.in[IN_B2] + (size_t)l * D, mod_vec(F, l, 0, 5), NMOD, T, ALPHA}; run_gemm(F, U, (const bf16*)(ws + WS_W2) + (size_t)l * D * FF, M, D, FF, E); } PHASE_END
        PHASE_BEGIN if constexpr (ON(12)) {
            const bool last = (l == DEPTH - 1); const int ln = last ? l : l + 1;
            const float* kvm = (const float*)(ws + WS_MOD) + (size_t)DEPTH * NB * NMOD;
            ph_ln(F, TB, last ? args.out : XA, args.in[IN_LNG] + (size_t)(l * 2 + 1) * D, args.in[IN_LNB] + (size_t)(l * 2 + 1) * D, mod_vec(F, ln, 0, 1), mod_vec(F, ln, 0, 0), NMOD, last ? nullptr : HA,
                  kvm + D, kvm, 2 * D, (l == NA - 1) ? (bf16*)(mix + MX_HKV) : nullptr);
        } PHASE_END
    }
#undef PHASE_BEGIN
#undef PHASE_END
}

extern "C" void kernel_launch(void* const* d_in, const int* in_sizes, int n_in, void* d_out, int out_size, void* d_ws, size_t ws_size, hipStream_t stream) {
    static int grid = 0;
    if (grid == 0) {
        if (n_in != 20 || in_sizes[0] != M * D || out_size != M * D || ws_size < WS_END) { fprintf(stderr, "kernel_launch: shape/workspace mismatch: n_in %d in0 %d out %d ws %zu (need %zu)\n", n_in, n_in > 0 ? in_sizes[0] : -1, out_size, ws_size, (size_t)WS_END); grid = -1; return; }
        int dev = 0, cus = 0, per_cu = 0;
        if (hipGetDevice(&dev) != hipSuccess || hipDeviceGetAttribute(&cus, hipDeviceAttributeMultiprocessorCount, dev) != hipSuccess) { grid = -1; return; }
        if (hipFuncSetAttribute((const void*)yoco_fwd, hipFuncAttributeMaxDynamicSharedMemorySize, LDS_BYTES) != hipSuccess) { fprintf(stderr, "kernel_launch: hipFuncSetAttribute failed\n"); grid = -1; return; }
        if (hipOccupancyMaxActiveBlocksPerMultiprocessor(&per_cu, (const void*)yoco_fwd, NTHREADS, LDS_BYTES) != hipSuccess || per_cu < 1) fprintf(stderr, "kernel_launch: occupancy query reports %d\n", per_cu);
        (void)hipGetLastError();
        grid = cus;
        if (grid != 256) fprintf(stderr, "kernel_launch: %d CUs (built for 256)\n", grid);
    }
    if (grid < 0) return;
    if (hipMemsetAsync((char*)d_ws + WS_CTL, 0, CTL_ZERO_BYTES, stream) != hipSuccess) return;
    Args a{};
    for (int i = 0; i < 20; ++i) a.in[i] = (const float*)d_in[i];
    a.out = (float*)d_out; a.ws = (unsigned char*)d_ws;
#if MK_SPLIT
    for (int p = 0; p < N_PHASES; ++p) { a.ph_lo = p; a.ph_hi = p + 1; a.li = 0; hipLaunchKernelGGL(yoco_fwd, dim3(grid), dim3(NTHREADS), LDS_BYTES, stream, a); }
#else
    a.ph_lo = 0; a.ph_hi = N_PHASES; a.li = 0;
    hipLaunchKernelGGL(yoco_fwd, dim3(grid), dim3(NTHREADS), LDS_BYTES, stream, a);
#endif
    const hipError_t le = hipPeekAtLastError();
    if (le != hipSuccess) fprintf(stderr, "kernel_launch: launch failed: %s\n", hipGetErrorName(le));
}
```

```cpp
#include <hip/hip_runtime.h>
#include <cstdio>
#include <cstdint>
#ifndef SEGPROBE
#define SEGPROBE 0
#endif
namespace pg8 {
#define PG8_LAS __attribute__((address_space(3)))
typedef unsigned short bf16_t;
typedef short bf16x8 __attribute__((ext_vector_type(8)));
typedef float f32x4 __attribute__((ext_vector_type(4)));
typedef unsigned u32x4 __attribute__((ext_vector_type(4)));
constexpr int BM = 256, BK = 64, HALF = 128, HTB = HALF * BK * 2  , STAGE_BYTES = 8 * HTB, NXCD = 8, WGM = 8;

__host__ __device__ __forceinline__ int lds_byte(int r, int c) { const int st = (r >> 4) * 2 + (c >> 5), rr = r & 15, cc = c & 31, ob = rr * 64 + cc * 2; return st * 1024 + (ob ^ (((ob >> 9) & 1) << 5)); }
__host__ __device__ __forceinline__ void stage_rc(int b, int& R, int& C) { const int st = b / 1024, sb = b % 1024, swz = sb ^ (((sb >> 9) & 1) << 5); R = (st >> 1) * 16 + swz / 64; C = (st & 1) * 32 + (swz % 64) / 2; }
__host__ __device__ __forceinline__ int perm32(int rho) { const int n = rho >> 4, i = rho & 15; return 8 * (i >> 2) + 4 * n + (i & 3); }

struct Unit { int pm, pn; };
struct Gemm { const bf16_t* A; const bf16_t* Bt; int M, N, K; };

struct StaticOrder {
    int nM, nN, nwg, G, c;
    __host__ __device__ __forceinline__ void init(int M, int N, int G_, int c_) { nM = M / BM; nN = N / BM; nwg = nM * nN; G = G_; c = c_; }
    __host__ __device__ __forceinline__ bool next(int i, Unit& u) const {
        const long L = (long)i * G + c; if (L >= nwg) return false;
        int wgid = (int)L; { const int q = nwg / NXCD, r = nwg % NXCD, xcd = wgid % NXCD, off = wgid / NXCD; wgid = (xcd < r ? xcd * (q + 1) : r * (q + 1) + (xcd - r) * q) + off; }
        const int nig = WGM * nN, gid = wgid / nig, fm = gid * WGM, gsz = (nM - fm) < WGM ? (nM - fm) : WGM;
        u.pm = fm + ((wgid % nig) % gsz); u.pn = (wgid % nig) / gsz; return true;
    }
    __device__ __forceinline__ void a_ready(const Unit&) const {}
    __device__ __forceinline__ void done(const Unit&) const {}
};

__device__ __forceinline__ unsigned cvt_pk_bf16(float lo, float hi) { unsigned r; asm volatile("v_cvt_pk_bf16_f32 %0, %1, %2" : "=v"(r) : "v"(lo), "v"(hi)); return r; }
typedef float f32x2 __attribute__((ext_vector_type(2)));

struct EpiBf16Seg {
    static constexpr bool PERM = true, AFTER_DRAIN = false, HEADSCALE = false;
    bf16_t* O0; bf16_t* O1; bf16_t* O2; int ld0, ld1, ld2, t1, t2; float scale0; int fragmask;
    __device__ __forceinline__ void operator()(const f32x4 (&acc)[2][2][4][2], const Unit& u, int wr, int wc, int fr, int fq, int  ) const {
        const int row0 = u.pm * BM + wr * 64 + fr;
        bf16_t* base; int ld, ct, seg; float sc = 1.f;
        if (u.pn < t1) { base = O0; ld = ld0; ct = u.pn; sc = scale0; seg = 0; } else if (u.pn < t2) { base = O1; ld = ld1; ct = u.pn - t1; seg = 1; } else { base = O2; ld = ld2; ct = u.pn - t2; seg = 2; }
        const bool frag = (fragmask >> seg) & 1;
        const int col0 = ct * BM + wc * 32 + 8 * fq;
#pragma unroll
        for (int ai = 0; ai < 2; ++ai)
#pragma unroll
            for (int m = 0; m < 4; ++m) { const int r = row0 + ai * HALF + m * 16; bf16_t* rowp = base + (size_t)r * ld + col0;
#pragma unroll
                for (int bj = 0; bj < 2; ++bj) { const f32x4 v0 = acc[ai][bj][m][0] * sc, v1 = acc[ai][bj][m][1] * sc;
                    u32x4 w; w.x = cvt_pk_bf16(v0[0], v0[1]); w.y = cvt_pk_bf16(v0[2], v0[3]); w.z = cvt_pk_bf16(v1[0], v1[1]); w.w = cvt_pk_bf16(v1[2], v1[3]);
                    bf16_t* p = rowp + bj * HALF;
                    if (frag && seg < 2) { const int d = wc * 32 + 8 * fq + bj * HALF;
                        p = base + (((((size_t)(r >> 6) * 4 + ct) * 2 + ((r >> 5) & 1)) * 16 + (d >> 4)) * 32 + (r & 31)) * 16 + ((d >> 3) & 1) * 8; }
                    else if (frag) { const int c = col0 + bj * HALF;
                        p = base + (((((size_t)(r >> 6) * 128 + (c >> 4)) * 4 + ((r >> 4) & 3)) * 2 + ((c >> 3) & 1)) * 16 + (r & 15)) * 8; }
                    *(u32x4*)p = w; } }
    }
};
struct EpiBf16Frag {
    static constexpr bool PERM = true, AFTER_DRAIN = false, HEADSCALE = false;
    bf16_t* O; int mode; float scale;
    __device__ __forceinline__ void operator()(const f32x4 (&acc)[2][2][4][2], const Unit& u, int wr, int wc, int fr, int fq, int  ) const {
        constexpr int SEQ = 4096, NH = 16, NT = SEQ / 32;
        const int row0 = u.pm * BM + wr * 64 + fr, col0 = u.pn * BM + wc * 32 + 8 * fq;
#pragma unroll
        for (int ai = 0; ai < 2; ++ai)
#pragma unroll
            for (int m = 0; m < 4; ++m) { const int r = row0 + ai * HALF + m * 16;
#pragma unroll
                for (int bj = 0; bj < 2; ++bj) { const int c = col0 + bj * HALF; size_t off;
                    if (mode < 2) { const int b = r / SEQ, t = r % SEQ, h = c >> 7, d = c & 127, kk = t & 31;
                        const int slot = mode == 0 ? kk : ((kk & 3) + 4 * (kk >> 4) + 8 * ((kk >> 2) & 3));
                        off = ((((size_t)(b * NH + h) * NT + (t >> 5)) * 8 + (d >> 4)) * 32 + slot) * 16 + ((d >> 3) & 1) * 8; }
                    else if (mode == 3) { off = (((size_t)(c >> 6) * 128 + (r >> 4)) * 2 + ((c >> 5) & 1)) * 512 + ((r & 15) + 16 * ((c >> 3) & 3)) * 8; }
                    else { const int h = r >> 7, d = r & 127, b = c / SEQ, t = c % SEQ, w = t & 31;
                        off = (((((size_t)(b * NH + h) * NT + (t >> 5)) * 4 + (d >> 5)) * 2 + ((w >> 3) & 1)) * 32 + (d & 31)) * 16 + (w >> 4) * 8; }
                    const f32x4 v0 = acc[ai][bj][m][0] * scale, v1 = acc[ai][bj][m][1] * scale;
                    u32x4 w4; w4.x = cvt_pk_bf16(v0[0], v0[1]); w4.y = cvt_pk_bf16(v0[2], v0[3]); w4.z = cvt_pk_bf16(v1[0], v1[1]); w4.w = cvt_pk_bf16(v1[2], v1[3]);
                    *(u32x4*)(O + off) = w4; } }
    }
};
struct EpiSqRelu {
    static constexpr bool PERM = true, AFTER_DRAIN = false, HEADSCALE = false;
    bf16_t* O; int ldc; const PG8_LAS float* lbias;
    __device__ __forceinline__ void operator()(const f32x4 (&acc)[2][2][4][2], const Unit& u, int wr, int wc, int fr, int fq, int ui) const {
        const int row0 = u.pm * BM + wr * 64 + fr, col0 = u.pn * BM + wc * 32 + 8 * fq;
        const PG8_LAS float* bp = lbias + ui * 256 + wc * 32 + 8 * fq;
#pragma unroll
        for (int ai = 0; ai < 2; ++ai)
#pragma unroll
            for (int m = 0; m < 4; ++m) { bf16_t* rowp = O + (size_t)(row0 + ai * HALF + m * 16) * ldc + col0;
#pragma unroll
                for (int bj = 0; bj < 2; ++bj) { f32x4 v0 = acc[ai][bj][m][0] + *(const PG8_LAS f32x4*)(bp + bj * HALF), v1 = acc[ai][bj][m][1] + *(const PG8_LAS f32x4*)(bp + bj * HALF + 4);
                    v0 = __builtin_elementwise_max(v0, (f32x4){0.f, 0.f, 0.f, 0.f}); v1 = __builtin_elementwise_max(v1, (f32x4){0.f, 0.f, 0.f, 0.f}); v0 = v0 * v0; v1 = v1 * v1;
                    u32x4 w; w.x = cvt_pk_bf16(v0[0], v0[1]); w.y = cvt_pk_bf16(v0[2], v0[3]); w.z = cvt_pk_bf16(v1[0], v1[1]); w.w = cvt_pk_bf16(v1[2], v1[3]);
                    *(u32x4*)(rowp + bj * HALF) = w; } }
    }
};

struct EpiResidT {
    static constexpr bool PERM = true, AFTER_DRAIN = false, HEADSCALE = true;
    const bf16_t* X; bf16_t* Tt; int ldc; const float* gate; int gstride, rows_per_batch; float alpha;
    int hs_on; const float* RS; PG8_LAS float* hs_tab;
    __device__ __forceinline__ f32x4 hs_load(const Unit& u, int tid) const { return tid < 256 ? *(const f32x4*)(RS + (size_t)(u.pm * BM + tid) * 4) : (f32x4){1.f, 1.f, 1.f, 1.f}; }
    __device__ __forceinline__ void hs_store(const f32x4 v, int ui, int tid) const { if (tid < 256) *(PG8_LAS f32x4*)(hs_tab + (ui & 1) * 1024 + tid * 4) = v; }
    __device__ __forceinline__ void hs_scale(f32x4 (&acc)[2][2][4][2], int ui, int seg, int wr) const {
        int t2 = threadIdx.x; asm volatile("" : "+v"(t2)); const int fr = t2 & 15;
        const PG8_LAS float* tb = hs_tab + (ui & 1) * 1024 + (wr * 64 + fr) * 4 + seg;
#pragma unroll
        for (int ai = 0; ai < 2; ++ai)
#pragma unroll
            for (int m = 0; m < 4; ++m) { const float rho = tb[(ai * HALF + m * 16) * 4];
#pragma unroll
                for (int bj = 0; bj < 2; ++bj)
#pragma unroll
                    for (int n = 0; n < 2; ++n) acc[ai][bj][m][n] *= rho; }
    }
    __device__ __forceinline__ void operator()(const f32x4 (&acc)[2][2][4][2], const Unit& u, int wr, int wc, int fr, int fq, int ui) const {
        const int row0 = u.pm * BM + wr * 64 + fr, col0 = u.pn * BM + wc * 32 + 8 * fq;
        const float* gp = gate + (size_t)((u.pm * BM) / rows_per_batch) * gstride + col0;
        const PG8_LAS float* tb = hs_tab + (ui & 1) * 1024 + (wr * 64 + fr) * 4 + 3;
        f32x4 gv[2][2];
#pragma unroll
        for (int bj = 0; bj < 2; ++bj)
#pragma unroll
            for (int n = 0; n < 2; ++n) gv[bj][n] = *(const f32x4*)(gp + bj * HALF + 4 * n) + 1.0f;
#pragma unroll
        for (int ai = 0; ai < 2; ++ai) {
            u32x4 xw[4][2];
#pragma unroll
            for (int m = 0; m < 4; ++m)
#pragma unroll
                for (int bj = 0; bj < 2; ++bj) xw[m][bj] = *(const u32x4*)(X + (size_t)(row0 + ai * HALF + m * 16) * ldc + col0 + bj * HALF);
#pragma unroll
            for (int m = 0; m < 4; ++m) { const size_t off = (size_t)(row0 + ai * HALF + m * 16) * ldc + col0;
                const float rs3 = hs_on ? tb[(ai * HALF + m * 16) * 4] : 1.0f;
#pragma unroll
                for (int bj = 0; bj < 2; ++bj) { const u32x4 w = xw[m][bj];
                    const f32x4 x0 = {__builtin_bit_cast(float, w.x << 16), __builtin_bit_cast(float, w.x & 0xffff0000u), __builtin_bit_cast(float, w.y << 16), __builtin_bit_cast(float, w.y & 0xffff0000u)};
                    const f32x4 x1 = {__builtin_bit_cast(float, w.z << 16), __builtin_bit_cast(float, w.z & 0xffff0000u), __builtin_bit_cast(float, w.w << 16), __builtin_bit_cast(float, w.w & 0xffff0000u)};
                    const f32x4 t0 = x0 * alpha + gv[bj][0] * (acc[ai][bj][m][0] * rs3), t1 = x1 * alpha + gv[bj][1] * (acc[ai][bj][m][1] * rs3);
                    u32x4 o; o.x = cvt_pk_bf16(t0[0], t0[1]); o.y = cvt_pk_bf16(t0[2], t0[3]); o.z = cvt_pk_bf16(t1[0], t1[1]); o.w = cvt_pk_bf16(t1[2], t1[3]);
                    *(u32x4*)(Tt + off + bj * HALF) = o; }
                }
        }
    }
};

struct EpiResidT2 {
    static constexpr bool PERM = true, AFTER_DRAIN = false, HEADSCALE = false;
    const bf16_t* Tin; const float* stats1; const float* g1v; const float* b1v; bf16_t* Tt; int ldc; const float* bias; const float* gate; int gstride, rows_per_batch; float alpha;
    __device__ __forceinline__ void operator()(const f32x4 (&acc)[2][2][4][2], const Unit& u, int wr, int wc, int fr, int fq, int ui) const {
        typedef float f32x2v __attribute__((ext_vector_type(2)));
        const int row0 = u.pm * BM + wr * 64 + fr, col0 = u.pn * BM + wc * 32 + 8 * fq;
        const float* gp = gate + (size_t)((u.pm * BM) / rows_per_batch) * gstride;
        f32x2v rs[2][4];
#pragma unroll
        for (int ai = 0; ai < 2; ++ai)
#pragma unroll
            for (int m = 0; m < 4; ++m) rs[ai][m] = *(const f32x2v*)(stats1 + (size_t)(row0 + ai * HALF + m * 16) * 2);
#pragma unroll
        for (int bj = 0; bj < 2; ++bj) { const int c = col0 + bj * HALF;
            f32x4 gv[2], bv[2], ga[2], ba[2];
#pragma unroll
            for (int n = 0; n < 2; ++n) { gv[n] = *(const f32x4*)(gp + c + 4 * n) + 1.0f; bv[n] = *(const f32x4*)(bias + c + 4 * n); ga[n] = *(const f32x4*)(g1v + c + 4 * n) * alpha; ba[n] = *(const f32x4*)(b1v + c + 4 * n) * alpha; }
#pragma unroll
            for (int ai = 0; ai < 2; ++ai) {
                u32x4 tw[4];
#pragma unroll
                for (int m = 0; m < 4; ++m) tw[m] = *(const u32x4*)(Tin + (size_t)(row0 + ai * HALF + m * 16) * ldc + c);
#pragma unroll
                for (int m = 0; m < 4; ++m) { const size_t off = (size_t)(row0 + ai * HALF + m * 16) * ldc + c; const u32x4 w = tw[m];
                    const f32x4 x0 = {__builtin_bit_cast(float, w.x << 16), __builtin_bit_cast(float, w.x & 0xffff0000u), __builtin_bit_cast(float, w.y << 16), __builtin_bit_cast(float, w.y & 0xffff0000u)};
                    const f32x4 x1 = {__builtin_bit_cast(float, w.z << 16), __builtin_bit_cast(float, w.z & 0xffff0000u), __builtin_bit_cast(float, w.w << 16), __builtin_bit_cast(float, w.w & 0xffff0000u)};
                    const float mu = rs[ai][m].x, rd = rs[ai][m].y;
                    const f32x4 t0 = ((x0 - mu) * rd) * ga[0] + ba[0] + gv[0] * (acc[ai][bj][m][0] + bv[0]), t1 = ((x1 - mu) * rd) * ga[1] + ba[1] + gv[1] * (acc[ai][bj][m][1] + bv[1]);
                    u32x4 o; o.x = cvt_pk_bf16(t0[0], t0[1]); o.y = cvt_pk_bf16(t0[2], t0[3]); o.z = cvt_pk_bf16(t1[0], t1[1]); o.w = cvt_pk_bf16(t1[2], t1[3]);
                    *(u32x4*)(Tt + off) = o; }
                } }
    }
};


template <class Epi, class Sched, bool ALIGN_EPI = false, bool SP2 = false>
__device__ __forceinline__ void gemm_phase(PG8_LAS unsigned char* lds, const Gemm g, const Sched& S, const Epi& E) {
    int tid_ = threadIdx.x; asm volatile("" : "+v"(tid_));
    const int tid = tid_, wid = __builtin_amdgcn_readfirstlane(tid >> 6), lane = tid & 63, wr = wid >> 2, wc = wid & 3, fr = lane & 15, fq = lane >> 4;
    const int K = g.K, nt = K / BK;
    unsigned voffA[2], voffB[2];
#pragma unroll
    for (int i = 0; i < 2; ++i) { int R, C; stage_rc(tid * 16 + i * 8192, R, C); const int Rb = Epi::PERM ? ((R & ~31) + perm32(R & 31)) : R;
        voffA[i] = (unsigned)(R * K + C) * 2u; voffB[i] = (unsigned)(Rb * K + C) * 2u; }
    const size_t kstep = (size_t)(BK * 2);
    const size_t hstep = (size_t)HALF * K * 2;
    const size_t tstep = 2 * hstep;
    const unsigned ldsw = (unsigned)wid * 1024u;
    const int aoff = lds_byte(wr * 64 + fr, fq * 8), boff = lds_byte(wc * 32 + fr, fq * 8);
#define PG8_SA(b, h) (((b) * 2 + (h)) * HTB)
#define PG8_SB(b, h) ((4 + (b) * 2 + (h)) * HTB)
#define PG8_STAGE(bufoff, gbase, voff) do { _Pragma("unroll") for (int _i = 0; _i < 2; ++_i) \
        __builtin_amdgcn_global_load_lds((const unsigned*)((const char*)(gbase) + (voff)[_i]), (PG8_LAS unsigned*)(lds + (bufoff) + ldsw + _i * 8192), 16, 0, 0); } while (0)
#define PG8_LDA(dst, b, h) do { _Pragma("unroll") for (int m = 0; m < 4; ++m) _Pragma("unroll") for (int k = 0; k < 2; ++k) dst[m][k] = *(const PG8_LAS bf16x8*)(lds + PG8_SA(b, h) + aoff + m * 2048 + k * 1024); } while (0)
#define PG8_LDB(dst, b, h) do { _Pragma("unroll") for (int n = 0; n < 2; ++n) _Pragma("unroll") for (int k = 0; k < 2; ++k) dst[n][k] = *(const PG8_LAS bf16x8*)(lds + PG8_SB(b, h) + boff + n * 2048 + k * 1024); } while (0)
#define PG8_MMA(ai, bj, At, Bt) do { __builtin_amdgcn_s_setprio(1); _Pragma("unroll") for (int m = 0; m < 4; ++m) _Pragma("unroll") for (int n = 0; n < 2; ++n) _Pragma("unroll") for (int k = 0; k < 2; ++k) \
        acc[ai][bj][m][n] = __builtin_amdgcn_mfma_f32_16x16x32_bf16(Bt[n][k], At[m][k], acc[ai][bj][m][n], 0, 0, 0); __builtin_amdgcn_s_setprio(0); } while (0)
#define PG8_WAIT_V(n) asm volatile("s_waitcnt vmcnt(" #n ")" ::: "memory")
#define PG8_WAIT_L(n) asm volatile("s_waitcnt lgkmcnt(" #n ")" ::: "memory")
#define PG8_BAR __builtin_amdgcn_s_barrier()
#define PG8_SCHED __builtin_amdgcn_sched_barrier(0)
    Unit cur, nxt; int ui = 0;
    if (!S.next(0, cur)) return;
    f32x4 acc[2][2][4][2];
#pragma unroll
    for (int a = 0; a < 2; ++a)
#pragma unroll
        for (int b = 0; b < 2; ++b)
#pragma unroll
            for (int m = 0; m < 4; ++m)
#pragma unroll
                for (int n = 0; n < 2; ++n) acc[a][b][m][n] = (f32x4){0.f, 0.f, 0.f, 0.f};
    bf16x8 At[4][2], B0[2][2], B1[2][2];
    const char* cA = (const char*)g.A + (size_t)cur.pm * tstep; const char* cB = (const char*)g.Bt + (size_t)cur.pn * tstep;
    S.a_ready(cur);
    f32x4 hs_nxt = (f32x4){0.f, 0.f, 0.f, 0.f};
    if constexpr (Epi::HEADSCALE) { if (E.hs_on) E.hs_store(E.hs_load(cur, tid), 0, tid); }
    if constexpr (SP2) {
        PG8_STAGE(PG8_SB(0, 0), cB, voffB); PG8_STAGE(PG8_SB(0, 1), cB + hstep, voffB); PG8_STAGE(PG8_SA(0, 0), cA, voffA); PG8_STAGE(PG8_SA(0, 1), cA + hstep, voffA);
        if (wr == 1) PG8_BAR;
        PG8_WAIT_V(2); PG8_BAR;
        PG8_STAGE(PG8_SB(1, 0), cB + kstep, voffB); PG8_STAGE(PG8_SA(1, 0), cA + kstep, voffA); PG8_STAGE(PG8_SB(1, 1), cB + hstep + kstep, voffB);
        PG8_WAIT_V(6); PG8_BAR;
    } else {
        PG8_STAGE(PG8_SB(0, 0), cB, voffB); PG8_STAGE(PG8_SA(0, 0), cA, voffA); PG8_STAGE(PG8_SB(0, 1), cB + hstep, voffB); PG8_STAGE(PG8_SA(0, 1), cA + hstep, voffA);
        if (wr == 1) PG8_BAR;
        PG8_WAIT_V(4); PG8_BAR;
        PG8_STAGE(PG8_SB(1, 0), cB + kstep, voffB); PG8_STAGE(PG8_SA(1, 0), cA + kstep, voffA); PG8_STAGE(PG8_SB(1, 1), cB + hstep + kstep, voffB);
        PG8_WAIT_V(6); PG8_BAR;
    }
    for (;;) {
        const bool has_next = S.next(ui + 1, nxt);
        const char* nA = has_next ? (const char*)g.A + (size_t)nxt.pm * tstep : cA; const char* nB = has_next ? (const char*)g.Bt + (size_t)nxt.pn * tstep : cB;
        for (int t = 0; t < nt; t += 2) {
            const bool last = (t == nt - 2);
            const char* a1 = cA + (size_t)(t + 1) * kstep;
            const char* a2 = last ? nA : cA + (size_t)(t + 2) * kstep; const char* b2 = last ? nB : cB + (size_t)(t + 2) * kstep;
            const char* a3 = a2 + kstep; const char* b3 = b2 + kstep;
            if (last && has_next) S.a_ready(nxt);
            if constexpr (Epi::HEADSCALE) { if (E.hs_on && last && has_next) hs_nxt = E.hs_load(nxt, tid); }
            if constexpr (SP2) {
            PG8_LDB(B0, 0, 0); PG8_LDB(B1, 0, 1); PG8_SCHED; PG8_LDA(At, 0, 0); PG8_STAGE(PG8_SA(1, 1), a1 + hstep, voffA);
            PG8_WAIT_V(8); PG8_WAIT_L(0); PG8_BAR; PG8_MMA(0, 0, At, B0); PG8_MMA(0, 1, At, B1); PG8_BAR; PG8_SCHED;
            PG8_LDA(At, 0, 1); PG8_STAGE(PG8_SB(0, 0), b2, voffB); PG8_STAGE(PG8_SB(0, 1), b2 + hstep, voffB); PG8_STAGE(PG8_SA(0, 0), a2, voffA);
            PG8_WAIT_V(8); PG8_WAIT_L(0); PG8_BAR; PG8_MMA(1, 0, At, B0); PG8_MMA(1, 1, At, B1); PG8_BAR; PG8_SCHED;
            PG8_LDB(B0, 1, 0); PG8_LDB(B1, 1, 1); PG8_SCHED; PG8_LDA(At, 1, 0); PG8_STAGE(PG8_SA(0, 1), a2 + hstep, voffA);
            PG8_WAIT_V(8); PG8_WAIT_L(0); PG8_BAR; PG8_MMA(0, 0, At, B0); PG8_MMA(0, 1, At, B1); PG8_BAR; PG8_SCHED;
            PG8_LDA(At, 1, 1); PG8_STAGE(PG8_SB(1, 0), b3, voffB); PG8_STAGE(PG8_SB(1, 1), b3 + hstep, voffB); PG8_STAGE(PG8_SA(1, 0), a3, voffA);
            PG8_WAIT_V(8); PG8_WAIT_L(0); PG8_BAR; PG8_MMA(1, 0, At, B0); PG8_MMA(1, 1, At, B1); PG8_BAR; PG8_SCHED;
            } else {
            PG8_LDB(B0, 0, 0); PG8_SCHED; PG8_LDA(At, 0, 0); PG8_STAGE(PG8_SA(1, 1), a1 + hstep, voffA);
            PG8_WAIT_L(8); PG8_BAR; PG8_WAIT_L(0); PG8_MMA(0, 0, At, B0); PG8_BAR; PG8_SCHED;
            PG8_LDB(B1, 0, 1); PG8_STAGE(PG8_SB(0, 0), b2, voffB);
            PG8_BAR; PG8_WAIT_L(0); PG8_MMA(0, 1, At, B1); PG8_BAR;
            PG8_LDA(At, 0, 1); PG8_STAGE(PG8_SA(0, 0), a2, voffA);
            PG8_BAR; PG8_WAIT_L(0); PG8_MMA(1, 0, At, B0); PG8_BAR; PG8_SCHED;
            PG8_STAGE(PG8_SB(0, 1), b2 + hstep, voffB);
            PG8_WAIT_V(6); PG8_BAR; PG8_MMA(1, 1, At, B1); PG8_BAR;
            PG8_LDB(B0, 1, 0); PG8_SCHED; PG8_LDA(At, 1, 0); PG8_STAGE(PG8_SA(0, 1), a2 + hstep, voffA);
            PG8_WAIT_L(8); PG8_BAR; PG8_WAIT_L(0); PG8_MMA(0, 0, At, B0); PG8_BAR; PG8_SCHED;
            PG8_LDB(B1, 1, 1); PG8_STAGE(PG8_SB(1, 0), b3, voffB);
            PG8_BAR; PG8_WAIT_L(0); PG8_MMA(0, 1, At, B1); PG8_BAR;
            PG8_LDA(At, 1, 1); PG8_STAGE(PG8_SA(1, 0), a3, voffA);
            PG8_BAR; PG8_WAIT_L(0); PG8_MMA(1, 0, At, B0); PG8_BAR; PG8_SCHED;
            PG8_STAGE(PG8_SB(1, 1), b3 + hstep, voffB);
            PG8_WAIT_V(6); PG8_BAR; PG8_MMA(1, 1, At, B1); PG8_BAR;
            }
            if constexpr (Epi::HEADSCALE) { if (E.hs_on && (t & 7) == 6 && !last) E.hs_scale(acc, ui, t >> 3, wr); }
        }
        if constexpr (ALIGN_EPI) { if (wr == 0) PG8_BAR; }
        if constexpr (!Epi::AFTER_DRAIN) { int t2_ = threadIdx.x; asm volatile("" : "+v"(t2_)); const int l2_ = t2_ & 63;
            E(acc, cur, wr, wc, l2_ & 15, l2_ >> 4, ui); S.done(cur);

            if constexpr (Epi::HEADSCALE) { if (E.hs_on && has_next) E.hs_store(hs_nxt, ui + 1, tid); } }
        if (!has_next) break;
#pragma unroll
        for (int a = 0; a < 2; ++a)
#pragma unroll
            for (int b = 0; b < 2; ++b)
#pragma unroll
                for (int m = 0; m < 4; ++m)
#pragma unroll
                    for (int n = 0; n < 2; ++n) acc[a][b][m][n] = (f32x4){0.f, 0.f, 0.f, 0.f};
        cur = nxt; cA = nA; cB = nB; ++ui;
        if constexpr (ALIGN_EPI) { if (wr == 1) PG8_BAR; }
    }
    PG8_WAIT_V(0);
    if constexpr (!ALIGN_EPI) { if (wr == 0) PG8_BAR; }
    PG8_BAR;
    if constexpr (Epi::AFTER_DRAIN) { int t2_ = threadIdx.x; asm volatile("" : "+v"(t2_)); const int l2_ = t2_ & 63; E.fused(acc, cur, wr, wc, l2_ & 15, l2_ >> 4, lds, wid, l2_); S.done(cur); }
#undef PG8_SA
#undef PG8_SB
#undef PG8_STAGE
#undef PG8_LDA
#undef PG8_LDB
#undef PG8_MMA
#undef PG8_WAIT_V
#undef PG8_WAIT_L
#undef PG8_BAR
#undef PG8_SCHED
}
}
#ifndef MK_SPLIT
#define MK_SPLIT 0
#endif
#ifndef GEMM_SP2
#define GEMM_SP2 true
#endif
#ifndef GEMM_ALIGN
#define GEMM_ALIGN true
#endif
#ifndef SEGPROBE
#define SEGPROBE 0
#endif
#define SEGPROBE_MUL 16
#ifndef SEGWAVE
#define SEGWAVE 0
#endif
constexpr int NWAVES = 8, NTHREADS = 512;

constexpr int NB = 4, T = 4096, D = 2048, M = NB * T, FF = 8192, DEPTH = 4, NA = 2;
constexpr int GH = 4, GDK = 256, GDV = 512, GQK = 1024, GVD = 2048, GRANK = 16, GCH = 64, GNIN = 6160;
constexpr int SH = 16, SHD = 128;
constexpr int NMOD = 6 * D;
constexpr int NENT = DEPTH * NB * NMOD + NB * 2 * D;
constexpr int KSPLIT = 8;
constexpr float ALPHA = 1.6817928305074290f;
constexpr float LN_EPS = 1e-5f, RMS_EPS = 1e-5f, LOG2E = 1.4426950408889634f;

constexpr size_t MiB = 1u << 20;
constexpr size_t WS_CTL = 0, CTL_ZERO_BYTES = 1 * MiB;
constexpr size_t WS_MOD = 1 * MiB;
constexpr size_t WS_PART = 2 * MiB;
constexpr size_t WS_SSQ = 9 * MiB;
constexpr size_t WS_DECAY = 17 * MiB;
constexpr size_t WS_WIN = 20 * MiB, WIN_STRIDE = 25 * MiB;
constexpr size_t WS_WGOUT = 70 * MiB;
constexpr size_t WS_WKV = 86 * MiB;
constexpr size_t WS_WQ = 102 * MiB, WS_WSOUT = 118 * MiB;
constexpr size_t WS_W1 = 134 * MiB, WS_W2 = 262 * MiB;
constexpr size_t WS_XA = 390 * MiB, WS_TB = 518 * MiB;
constexpr size_t WS_HA = 646 * MiB, WS_OG = 710 * MiB;
constexpr size_t WS_MIX = 774 * MiB;
constexpr size_t MX_Q = 0, MX_K = 32 * MiB, MX_R = 64 * MiB, MX_VT = 128 * MiB, MX_BC = 192 * MiB, MX_QD = 256 * MiB, MX_KST = 288 * MiB, MX_SM = 320 * MiB;
constexpr size_t MX_SQ = 0, MX_SK = 64 * MiB, MX_SVT = 128 * MiB, MX_HKV = 192 * MiB;
constexpr size_t WS_U = 1166 * MiB, WS_END = 1422 * MiB;
constexpr size_t WS_RS = 18 * MiB;
constexpr size_t WS_LNST = 18 * MiB + 512 * 1024;
constexpr int CW_TMO = 0, CW_BAR = 4096;

constexpr int RING_OFF = 0, RING_BYTES = 131072;
constexpr int LDSCTL_OFF = 163328, MISC_OFF = LDSCTL_OFF + 320;
constexpr int LDS_BYTES = 163840;

#define GAS __attribute__((address_space(1)))
#define LAS __attribute__((address_space(3)))
typedef unsigned short bf16;
typedef unsigned v4u __attribute__((ext_vector_type(4)));
typedef unsigned v2u __attribute__((ext_vector_type(2)));
typedef float f32x4 __attribute__((ext_vector_type(4)));
typedef short bf16x8 __attribute__((ext_vector_type(8)));
typedef GAS unsigned gu32;
#define RLX_AGENT __ATOMIC_RELAXED, __HIP_MEMORY_SCOPE_AGENT
#define LDS_WAIT() asm volatile("s_waitcnt lgkmcnt(0)" ::: "memory")
__device__ __forceinline__ unsigned f2bf(float f) { unsigned u = __builtin_bit_cast(unsigned, f); return (u + 0x7fffu + ((u >> 16) & 1u)) >> 16; }
__device__ __forceinline__ unsigned pk2(float lo, float hi) { unsigned r; asm("v_cvt_pk_bf16_f32 %0, %1, %2" : "=v"(r) : "v"(lo), "v"(hi)); return r; }
__device__ __forceinline__ float bf_lo(unsigned w) { return __builtin_bit_cast(float, w << 16); }
__device__ __forceinline__ float bf_hi(unsigned w) { return __builtin_bit_cast(float, w & 0xffff0000u); }
__device__ __forceinline__ float bf1(bf16 h) { return __builtin_bit_cast(float, (unsigned)h << 16); }
__device__ __forceinline__ float wave_sum(float v) {
#pragma unroll
    for (int o = 1; o < 64; o <<= 1) v += __shfl_xor(v, o);
    return v;
}
__device__ __forceinline__ float ex2(float x) { return __builtin_amdgcn_exp2f(x); }
__device__ __forceinline__ float lg2(float x) { return __builtin_amdgcn_logf(x); }
__device__ __forceinline__ float log2_sigmoid(float x) { const float z = x * LOG2E; return fminf(z, 0.f) - lg2(1.f + ex2(-fabsf(z))); }

#define XB_TMO      128
#define XB_XCNT(j)  (256  + 64 * (j))
#define XB_XSUB(j)  (1280 + 64 * (j))
#define XB_XGEN(j)  (2304 + 64 * (j))
#define XB_TOP      3328
#define XB_TOPGEN   3392
#define XCD_BAR_WORDS 3456
#define XB_SPIN_CAP (1u << 18)

__device__ __forceinline__ unsigned xb_ld(unsigned* p)              { return __hip_atomic_load(p, __ATOMIC_RELAXED, __HIP_MEMORY_SCOPE_AGENT); }
__device__ __forceinline__ unsigned xb_add(unsigned* p, unsigned v) { return __hip_atomic_fetch_add(p, v, __ATOMIC_RELAXED, __HIP_MEMORY_SCOPE_AGENT); }
__device__ __forceinline__ unsigned xb_xcc_id() { return (unsigned)__builtin_amdgcn_s_getreg((3 << 11) | 20) & 0xFu; }
#define XB_SPIN(cond, bar) do { unsigned _sp = 0; while (cond) { __builtin_amdgcn_s_sleep(1); \
    if ((++_sp & 255u) == 0u) { if (xb_ld(&(bar)[XB_TMO])) break; if (_sp > XB_SPIN_CAP) { atomicAdd(&(bar)[XB_TMO], 1u); break; } } } } while (0)

struct XcdBarrier {
    unsigned* bar; unsigned x;
    volatile LAS unsigned* st;
};

__device__ __forceinline__ XcdBarrier xcd_barrier_post(unsigned* bar, volatile LAS unsigned* st) {
    XcdBarrier b; b.bar = bar; b.x = xb_xcc_id(); b.st = st;
    if (threadIdx.x == 0) (void)xb_add(&bar[XB_XCNT(b.x)], 1u);
    return b;
}
__device__ __forceinline__ void xcd_barrier_complete(unsigned* bar, unsigned x, unsigned& nloc, unsigned& nx) {
    const unsigned G = gridDim.x * gridDim.y * gridDim.z;
    unsigned sum, cnt, mine, sp = 0u;
    for (;;) {
        sum = 0u; cnt = 0u; mine = 0u;
#pragma unroll
        for (unsigned j = 0; j < 16; ++j) { const unsigned c = xb_ld(&bar[XB_XCNT(j)]); sum += c; cnt += (c > 0u) ? 1u : 0u; mine = (j == x) ? c : mine; }
        if (sum == G) break;
        __builtin_amdgcn_s_sleep(1);
        if ((++sp & 255u) == 0u) { if (xb_ld(&bar[XB_TMO])) break; if (sp > XB_SPIN_CAP) { atomicAdd(&bar[XB_TMO], 1u); break; } }
    }
    nloc = mine > 0u ? mine : 1u; nx = cnt > 0u ? cnt : 1u;
}

__device__ __forceinline__ void xcd_barrier(const XcdBarrier& b) {
    asm volatile("s_waitcnt vmcnt(0)" ::: "memory");
    __syncthreads();
    if (threadIdx.x == 0) {
        unsigned* bar = b.bar;
        __builtin_amdgcn_s_waitcnt(0);
        unsigned nloc = b.st[0], nx = b.st[1];
        if (nloc == 0u) { xcd_barrier_complete(bar, b.x, nloc, nx); b.st[0] = nloc; b.st[1] = nx; }
        const unsigned old = xb_add(&bar[XB_XSUB(b.x)], 1u);
        const unsigned gen = old / nloc;
        if (old + 1u == (gen + 1u) * nloc) {
            __builtin_amdgcn_fence(__ATOMIC_RELEASE, "agent");
            asm volatile("s_waitcnt vmcnt(0)" ::: "memory");
            const unsigned og = xb_add(&bar[XB_TOP], 1u);
            const unsigned tg = og / nx;
            if (og + 1u == (tg + 1u) * nx) xb_add(&bar[XB_TOPGEN], 1u);
            else XB_SPIN(xb_ld(&bar[XB_TOPGEN]) == tg, bar);
            __builtin_amdgcn_fence(__ATOMIC_ACQUIRE, "agent");
            xb_add(&bar[XB_XGEN(b.x)], 1u);
            asm volatile("s_waitcnt vmcnt(0)" ::: "memory");
        } else {
            XB_SPIN(xb_ld(&bar[XB_XGEN(b.x)]) == gen, bar);
            __builtin_amdgcn_fence(__ATOMIC_ACQUIRE, "agent");
            asm volatile("s_waitcnt vmcnt(0)" ::: "memory");
        }
    }
    __syncthreads();
}
struct Args { const float* in[20]; float* out; unsigned char* ws; int ph_lo, ph_hi, li, pad; };
struct Frame {
    LAS unsigned char* lds;
    volatile LAS unsigned* MISC;
    gu32* ctl;
    int tid, lane, wave, vcu, G;
    unsigned char* ws;
};
enum { IN_X = 0, IN_C, IN_ADAW, IN_ADAB, IN_LNG, IN_LNB, IN_GWIN, IN_GWUP, IN_GBG, IN_GNG, IN_GWOUT, IN_KVADAW, IN_KVADAB, IN_WKV, IN_SWQ, IN_SWOUT, IN_W1, IN_B1, IN_W2, IN_B2 };
__device__ __forceinline__ const float* mod_vec(const Frame& F, int l, int b, int chunk) { return (const float*)(F.ws + WS_MOD) + (size_t)(l * NB + b) * NMOD + chunk * D; }

__device__ __forceinline__ void tr_item(const float* W, int ldw, int K, bf16* WT, int k0, int n0s, int nd0, LAS float* scr, int lane) {
    const int lr = lane >> 4, lc = 4 * (lane & 15);
#pragma unroll
    for (int i = 0; i < 16; ++i) { const int kk = 4 * i + lr; const f32x4 v = *(const f32x4*)(W + (size_t)(k0 + kk) * ldw + n0s + lc);
        LAS float* s = scr + kk * 65 + lc; s[0] = v[0]; s[1] = v[1]; s[2] = v[2]; s[3] = v[3]; }
    LDS_WAIT(); asm volatile("" ::: "memory");
    const int c = lane & 7;
#pragma unroll
    for (int j = 0; j < 8; ++j) { const int n = (lane >> 3) + 8 * j; const LAS float* s = scr + (8 * c) * 65 + n;
        v4u o; o.x = pk2(s[0 * 65], s[1 * 65]); o.y = pk2(s[2 * 65], s[3 * 65]); o.z = pk2(s[4 * 65], s[5 * 65]); o.w = pk2(s[6 * 65], s[7 * 65]);
        *(v4u*)(WT + (size_t)(nd0 + n) * K + k0 + 8 * c) = o; }
    LDS_WAIT(); asm volatile("" ::: "memory");
}
__device__ __forceinline__ void tr_matrix_item(const float* W, int ldw, int K, int N, bf16* WT, int item, int remap_win, LAS float* scr, int lane) {
    const int nblk = N / 64, kb = item / nblk, nb = item % nblk; int nd0 = 64 * nb;
    if (remap_win) { if (nd0 >= 2048 && nd0 < 4096) nd0 += 2048; else if (nd0 >= 4096) nd0 -= 2048; }
    tr_item(W, ldw, K, WT, 64 * kb, 64 * nb, nd0, scr, lane);
}
__device__ __forceinline__ int conv_items_of(int id) { return id < 2 ? 32 * 96 : id < 4 ? 32 * 32 : id == 4 ? 32 * 64 : id < 9 ? 32 * 32 : 32 * 128; }
__device__ __forceinline__ void conv_item(Frame& F, const Args& a, int id, int it, LAS float* scr) {
    const float* W; int ldw, K, N, remap = 0; bf16* WT;
    if (id < 2) { W = a.in[IN_GWIN] + (size_t)id * D * GNIN; ldw = GNIN; K = D; N = 6144; WT = (bf16*)(F.ws + WS_WIN + id * WIN_STRIDE); remap = 1; }
    else if (id < 4) { W = a.in[IN_GWOUT] + (size_t)(id - 2) * D * D; ldw = D; K = D; N = D; WT = (bf16*)(F.ws + WS_WGOUT) + (size_t)(id - 2) * D * D; }
    else if (id == 4) { W = a.in[IN_WKV]; ldw = 2 * D; K = D; N = 2 * D; WT = (bf16*)(F.ws + WS_WKV); }
    else if (id < 7) { W = a.in[IN_SWQ] + (size_t)(id - 5) * D * D; ldw = D; K = D; N = D; WT = (bf16*)(F.ws + WS_WQ) + (size_t)(id - 5) * D * D; }
    else if (id < 9) { W = a.in[IN_SWOUT] + (size_t)(id - 7) * D * D; ldw = D; K = D; N = D; WT = (bf16*)(F.ws + WS_WSOUT) + (size_t)(id - 7) * D * D; }
    else if (id < 13) { W = a.in[IN_W1] + (size_t)(id - 9) * D * FF; ldw = FF; K = D; N = FF; WT = (bf16*)(F.ws + WS_W1) + (size_t)(id - 9) * D * FF; }
    else { W = a.in[IN_W2] + (size_t)(id - 13) * D * FF; ldw = D; K = FF; N = D; WT = (bf16*)(F.ws + WS_W2) + (size_t)(id - 13) * D * FF; }
    tr_matrix_item(W, ldw, K, N, WT, it, remap, scr, F.lane);
}
template <int NM> __device__ __forceinline__ void conv_list(Frame& F, const Args& a, const int (&order)[NM], int gw, int ngw) {
    LAS float* scr = (LAS float*)(F.lds + F.wave * 16640);
    int total = 0;
#pragma unroll
    for (int q = 0; q < NM; ++q) total += conv_items_of(order[q]);
#pragma unroll 1
    for (int it = gw; it < total; it += ngw) {
        int id = order[0], r = it, base = 0;
#pragma unroll
        for (int q = 0; q < NM; ++q) { const int c = conv_items_of(order[q]); if (it >= base) { id = order[q]; r = it - base; } base += c; }
        conv_item(F, a, id, r, scr);
    }
}
__device__ __forceinline__ void ph_pro0(Frame& F, const Args& a) {
    LAS float* cs = (LAS float*)(F.lds);
    __syncthreads();
    for (int i = F.tid; i < NB * D; i += NTHREADS) { const float v = a.in[IN_C][i]; cs[i] = v / (1.f + __expf(-v)); }
    __syncthreads();
    const int gw = F.vcu * NWAVES + F.wave, NGW = F.G * NWAVES;
    for (int task = gw; task < 208 * KSPLIT; task += NGW) {
        const int cb = task / KSPLIT, ks = task % KSPLIT;
        const float* src; int ld, j0, ebase, estride;
        if (cb < 192) { const int l = cb / 48, jb = cb % 48; src = a.in[IN_ADAW] + (size_t)l * D * NMOD; ld = NMOD; j0 = jb * 256 + F.lane * 4; ebase = l * NB * NMOD; estride = NMOD; }
        else { const int jb = cb - 192; src = a.in[IN_KVADAW]; ld = 2 * D; j0 = jb * 256 + F.lane * 4; ebase = DEPTH * NB * NMOD; estride = 2 * D; }
        f32x4 acc[NB];
#pragma unroll
        for (int b = 0; b < NB; ++b) acc[b] = (f32x4){0.f, 0.f, 0.f, 0.f};
        const float* p = src + (size_t)(ks * 256) * ld + j0; const LAS float* cp = cs + ks * 256;
#pragma unroll 8
        for (int k = 0; k < 256; ++k) { const f32x4 w = *(const f32x4*)(p + (size_t)k * ld);
#pragma unroll
            for (int b = 0; b < NB; ++b) acc[b] += w * cp[b * D + k]; }
        float* part = (float*)(F.ws + WS_PART) + (size_t)ks * NENT + ebase + j0;
#pragma unroll
        for (int b = 0; b < NB; ++b) *(f32x4*)(part + (size_t)b * estride) = acc[b];
    }
    __syncthreads();
    {
        constexpr int order[17] = {0, 1, 2, 3, 4, 5, 6, 7, 8, 9, 10, 11, 12, 13, 14, 15, 16};
        conv_list<17>(F, a, order, gw, NGW);
    }
    for (int idx = blockIdx.x * NTHREADS + F.tid; idx < NA * 16 * 256; idx += F.G * NTHREADS) {
        const int l = idx / 4096, n = (idx % 4096) / 256, kc = idx % 256;
        const float* s = a.in[IN_GWIN] + (size_t)l * D * GNIN + (size_t)(8 * kc) * GNIN + 6144 + n;
        v4u o; o.x = pk2(s[0], s[GNIN]); o.y = pk2(s[2 * GNIN], s[3 * GNIN]); o.z = pk2(s[4 * GNIN], s[5 * GNIN]); o.w = pk2(s[6 * GNIN], s[7 * GNIN]);
        *(v4u*)((bf16*)(F.ws + WS_WIN + l * WIN_STRIDE) + (size_t)(6144 + n) * D + 8 * kc) = o;
    }
}

__device__ __forceinline__ float mod_entry(const Frame& F, const Args& a, int e) {
    float s = (e < DEPTH * NB * NMOD) ? a.in[IN_ADAB][(e / (NB * NMOD)) * NMOD + e % NMOD] : a.in[IN_KVADAB][(e - DEPTH * NB * NMOD) % (2 * D)];
    const float* part = (const float*)(F.ws + WS_PART) + e;
#pragma unroll
    for (int ks = 0; ks < KSPLIT; ++ks) s += part[(size_t)ks * NENT];
    return s;
}
__device__ __forceinline__ void ph_pro1(Frame& F, const Args& a) {
    float* MOD = (float*)(F.ws + WS_MOD);
    constexpr int PER = NENT / 256;
    for (int s = blockIdx.x; s < 256; s += F.G) for (int e = s * PER + F.tid; e < (s + 1) * PER; e += NTHREADS) MOD[e] = mod_entry(F, a, e);
    const int b = (blockIdx.x * 64) / T;
    LAS float* lsh = (LAS float*)F.lds; LAS float* lsc = lsh + D;
    for (int j = F.tid; j < 2 * D; j += NTHREADS) lsh[j] = mod_entry(F, a, b * NMOD + j);
    __syncthreads();
    for (int i0 = 0; i0 < 8; i0 += 2) {
        f32x4 xv[2][4][2];
#pragma unroll
        for (int i = 0; i < 2; ++i) { const f32x4* xr = (const f32x4*)(a.in[IN_X] + (size_t)(blockIdx.x * 64 + F.wave * 8 + i0 + i) * D) + 2 * F.lane;
#pragma unroll
            for (int j = 0; j < 4; ++j) { xv[i][j][0] = xr[128 * j]; xv[i][j][1] = xr[128 * j + 1]; } }
#pragma unroll
        for (int i = 0; i < 2; ++i) { const int m = blockIdx.x * 64 + F.wave * 8 + i0 + i;
            v4u* ho = (v4u*)((bf16*)(F.ws + WS_HA) + (size_t)m * D) + F.lane; v4u* xb = (v4u*)((bf16*)(F.ws + WS_XA) + (size_t)m * D) + F.lane;
#pragma unroll
            for (int j = 0; j < 4; ++j) { const int c = 8 * F.lane + 512 * j; const f32x4 x0 = xv[i][j][0], x1 = xv[i][j][1];
                const f32x4 h0 = x0 * (*(const LAS f32x4*)(lsc + c) + 1.0f) + *(const LAS f32x4*)(lsh + c), h1 = x1 * (*(const LAS f32x4*)(lsc + c + 4) + 1.0f) + *(const LAS f32x4*)(lsh + c + 4);
                v4u o; o.x = pk2(h0[0], h0[1]); o.y = pk2(h0[2], h0[3]); o.z = pk2(h1[0], h1[1]); o.w = pk2(h1[2], h1[3]); ho[64 * j] = o;
                v4u xo; xo.x = pk2(x0[0], x0[1]); xo.y = pk2(x0[2], x0[3]); xo.z = pk2(x1[0], x1[1]); xo.w = pk2(x1[2], x1[3]); xb[64 * j] = xo; } }
    }
}

__device__ __forceinline__ void ph_ln(Frame& F, const bf16* Tin, float* STATS, bf16* HAo, const float* g, const float* bta, const float* sc, const float* sh, int bstride) {
    const int b = (blockIdx.x * 64) / T;
    f32x4 gA[4][2], bA[4][2], sA[4][2], tA[4][2];
#pragma unroll
    for (int j = 0; j < 4; ++j)
#pragma unroll
        for (int n = 0; n < 2; ++n) { const int c = 8 * F.lane + 512 * j + 4 * n; gA[j][n] = *(const f32x4*)(g + c); bA[j][n] = *(const f32x4*)(bta + c);
            sA[j][n] = *(const f32x4*)(sc + (size_t)b * bstride + c) + 1.0f; tA[j][n] = *(const f32x4*)(sh + (size_t)b * bstride + c); }
    for (int i0 = 0; i0 < 8; i0 += 2) {
        v4u tw[2][4];
#pragma unroll
        for (int i = 0; i < 2; ++i) { const v4u* tr = (const v4u*)(Tin + (size_t)(blockIdx.x * 64 + F.wave * 8 + i0 + i) * D) + F.lane;
#pragma unroll
            for (int j = 0; j < 4; ++j) tw[i][j] = tr[64 * j]; }
#pragma unroll
        for (int i = 0; i < 2; ++i) { const int m = blockIdx.x * 64 + F.wave * 8 + i0 + i;
            f32x4 v[4][2]; float s = 0.f;
#pragma unroll
            for (int j = 0; j < 4; ++j) { const v4u w = tw[i][j];
                v[j][0] = (f32x4){bf_lo(w.x), bf_hi(w.x), bf_lo(w.y), bf_hi(w.y)}; v[j][1] = (f32x4){bf_lo(w.z), bf_hi(w.z), bf_lo(w.w), bf_hi(w.w)};
                s += ((v[j][0][0] + v[j][0][1]) + (v[j][0][2] + v[j][0][3])) + ((v[j][1][0] + v[j][1][1]) + (v[j][1][2] + v[j][1][3])); }
            const float mean = wave_sum(s) * (1.f / D); float s2 = 0.f;
#pragma unroll
            for (int j = 0; j < 4; ++j)
#pragma unroll
                for (int n = 0; n < 2; ++n) { v[j][n] = v[j][n] - mean; s2 += (v[j][n][0] * v[j][n][0] + v[j][n][1] * v[j][n][1]) + (v[j][n][2] * v[j][n][2] + v[j][n][3] * v[j][n][3]); }
            const float rstd = 1.f / sqrtf(wave_sum(s2) * (1.f / D) + LN_EPS);
            if (F.lane == 0) { typedef float f32x2s __attribute__((ext_vector_type(2))); *(f32x2s*)(STATS + (size_t)m * 2) = (f32x2s){mean, rstd}; }
            v4u* ho = (v4u*)(HAo + (size_t)m * D) + F.lane;
#pragma unroll
            for (int j = 0; j < 4; ++j) { const f32x4 x0 = v[j][0] * rstd * gA[j][0] + bA[j][0], x1 = v[j][1] * rstd * gA[j][1] + bA[j][1];
                const f32x4 h0 = x0 * sA[j][0] + tA[j][0], h1 = x1 * sA[j][1] + tA[j][1];
                v4u w2; w2.x = pk2(h0[0], h0[1]); w2.y = pk2(h0[2], h0[3]); w2.z = pk2(h1[0], h1[1]); w2.w = pk2(h1[2], h1[3]); ho[64 * j] = w2; }
        }
    }
}

__device__ __forceinline__ void ph_ln2(Frame& F, const bf16* Tin, bf16* XAo, float* Xf, bf16* HAo, bf16* H2o, const float* g, const float* bta, const float* sc, const float* sh, int bstride,
                                       const float* sc2, const float* sh2, int bstride2) {
    const int b = (blockIdx.x * 64) / T;
    f32x4 gA[4][2], bA[4][2], g2[4][2], b2[4][2];
#pragma unroll
    for (int j = 0; j < 4; ++j)
#pragma unroll
        for (int n = 0; n < 2; ++n) { const int c = 8 * F.lane + 512 * j + 4 * n; gA[j][n] = *(const f32x4*)(g + c); bA[j][n] = *(const f32x4*)(bta + c);
            if (HAo) { const f32x4 s1 = *(const f32x4*)(sc + (size_t)b * bstride + c) + 1.0f; g2[j][n] = gA[j][n] * s1; b2[j][n] = bA[j][n] * s1 + *(const f32x4*)(sh + (size_t)b * bstride + c); }
            else { g2[j][n] = gA[j][n]; b2[j][n] = bA[j][n]; } }
    for (int i0 = 0; i0 < 8; i0 += 2) {
        v4u tw[2][4];
#pragma unroll
        for (int i = 0; i < 2; ++i) { const v4u* tr = (const v4u*)(Tin + (size_t)(blockIdx.x * 64 + F.wave * 8 + i0 + i) * D) + F.lane;
#pragma unroll
            for (int j = 0; j < 4; ++j) tw[i][j] = tr[64 * j]; }
#pragma unroll
        for (int i = 0; i < 2; ++i) { const int m = blockIdx.x * 64 + F.wave * 8 + i0 + i;
            f32x4 v[4][2]; float s = 0.f;
#pragma unroll
            for (int j = 0; j < 4; ++j) { const v4u w = tw[i][j];
                v[j][0] = (f32x4){bf_lo(w.x), bf_hi(w.x), bf_lo(w.y), bf_hi(w.y)}; v[j][1] = (f32x4){bf_lo(w.z), bf_hi(w.z), bf_lo(w.w), bf_hi(w.w)};
                s += ((v[j][0][0] + v[j][0][1]) + (v[j][0][2] + v[j][0][3])) + ((v[j][1][0] + v[j][1][1]) + (v[j][1][2] + v[j][1][3])); }
            const float mean = wave_sum(s) * (1.f / D); float s2 = 0.f;
#pragma unroll
            for (int j = 0; j < 4; ++j)
#pragma unroll
                for (int n = 0; n < 2; ++n) { v[j][n] = v[j][n] - mean; s2 += (v[j][n][0] * v[j][n][0] + v[j][n][1] * v[j][n][1]) + (v[j][n][2] * v[j][n][2] + v[j][n][3] * v[j][n][3]); }
            const float rstd = 1.f / sqrtf(wave_sum(s2) * (1.f / D) + LN_EPS);
#pragma unroll
            for (int j = 0; j < 4; ++j) { const f32x4 xh0 = v[j][0] * rstd, xh1 = v[j][1] * rstd; const f32x4 x0 = xh0 * gA[j][0] + bA[j][0], x1 = xh1 * gA[j][1] + bA[j][1];
                if (Xf) { float* xo = Xf + (size_t)m * D + 8 * F.lane + 512 * j; *(f32x4*)xo = x0; *(f32x4*)(xo + 4) = x1; }
                else { v4u w; w.x = pk2(x0[0], x0[1]); w.y = pk2(x0[2], x0[3]); w.z = pk2(x1[0], x1[1]); w.w = pk2(x1[2], x1[3]); ((v4u*)(XAo + (size_t)m * D) + F.lane)[64 * j] = w; }
                if (HAo) { const f32x4 h0 = xh0 * g2[j][0] + b2[j][0], h1 = xh1 * g2[j][1] + b2[j][1];
                    v4u w2; w2.x = pk2(h0[0], h0[1]); w2.y = pk2(h0[2], h0[3]); w2.z = pk2(h1[0], h1[1]); w2.w = pk2(h1[2], h1[3]); ((v4u*)(HAo + (size_t)m * D) + F.lane)[64 * j] = w2; }
                if (H2o) { const int c = 8 * F.lane + 512 * j; const float* sp = sc2 + (size_t)b * bstride2 + c; const float* tp = sh2 + (size_t)b * bstride2 + c;
                    const f32x4 k0 = x0 * (*(const f32x4*)sp + 1.0f) + *(const f32x4*)tp, k1 = x1 * (*(const f32x4*)(sp + 4) + 1.0f) + *(const f32x4*)(tp + 4);
                    v4u w3; w3.x = pk2(k0[0], k0[1]); w3.y = pk2(k0[2], k0[3]); w3.z = pk2(k1[0], k1[1]); w3.w = pk2(k1[2], k1[3]); ((v4u*)(H2o + (size_t)m * D) + F.lane)[64 * j] = w3; } }
        }
    }
}

template <class Epi> __device__ __forceinline__ void run_gemm(Frame& F, const bf16* A, const bf16* Bt, int M_, int N_, int K_, const Epi& E) {
    pg8::Gemm g{A, Bt, M_, N_, K_}; pg8::StaticOrder S; S.init(M_, N_, F.G, (int)blockIdx.x);
    pg8::gemm_phase<Epi, pg8::StaticOrder, GEMM_ALIGN, GEMM_SP2>(F.lds + RING_OFF, g, S, E);
}


typedef float f32x16 __attribute__((ext_vector_type(16)));
__device__ __forceinline__ bf16x8 as_bf16x8(v4u v) { return __builtin_bit_cast(bf16x8, v); }
__device__ __forceinline__ unsigned cvtpk(float lo, float hi) { unsigned r; asm volatile("v_cvt_pk_bf16_f32 %0, %1, %2" : "=v"(r) : "v"(lo), "v"(hi)); return r; }

__device__ __forceinline__ void ph_gate(Frame& F, const Args& a, int l, const bf16* HA, const bf16* Wgl, float* BC, float* DECAY) {
    const int m0 = blockIdx.x * 64, lane = F.lane, fr = lane & 15, fq = lane >> 4, tt = F.wave & 3, kh = F.wave >> 2;
    LAS float* gls = (LAS float*)F.lds;
    {
        f32x4 acc = (f32x4){0.f, 0.f, 0.f, 0.f};
        const bf16* ap = HA + (size_t)(m0 + 16 * tt + fr) * D + 1024 * kh + 8 * fq; const bf16* bp = Wgl + (size_t)fr * D + 1024 * kh + 8 * fq;
#pragma unroll 8
        for (int s = 0; s < 32; ++s) acc = __builtin_amdgcn_mfma_f32_16x16x32_bf16(as_bf16x8(*(const v4u*)(ap + 32 * s)), as_bf16x8(*(const v4u*)(bp + 32 * s)), acc, 0, 0, 0);
#pragma unroll
        for (int i = 0; i < 4; ++i) gls[kh * 1024 + (16 * tt + 4 * fq + i) * 16 + fr] = acc[i];
    }
    __syncthreads();
    if (F.tid < 256) { const f32x4 v = *(const LAS f32x4*)(gls + 4 * F.tid) + *(const LAS f32x4*)(gls + 1024 + 4 * F.tid); *(LAS f32x4*)(gls + 4 * F.tid) = v; }
    __syncthreads();
#pragma unroll 1
    for (int cc = 0; cc < 2; ++cc) {
        const int c = F.tid + 512 * cc;
        float wup[16];
#pragma unroll
        for (int j = 0; j < 16; ++j) wup[j] = a.in[IN_GWUP][(size_t)l * GRANK * GQK + j * GQK + c];
        const float bg = a.in[IN_GBG][l * GQK + c];
        const size_t bcb = (((size_t)blockIdx.x * 4 + (c >> 8)) * 2 * 16 + ((c & 255) >> 4)) * 512 + ((c >> 3) & 1) * 8 + (c & 7);
        float run = 0.f;
#pragma unroll 4
        for (int t = 0; t < 64; ++t) {
            float x = bg;
#pragma unroll
            for (int q = 0; q < 4; ++q) { const f32x4 g = *(const LAS f32x4*)(gls + t * 16 + 4 * q); x += g[0] * wup[4 * q] + g[1] * wup[4 * q + 1] + g[2] * wup[4 * q + 2] + g[3] * wup[4 * q + 3]; }
            run += log2_sigmoid(x) * (1.f / 16.f);
            BC[bcb + (size_t)(t >> 5) * 8192 + (t & 31) * 16] = run;
        }
        DECAY[(size_t)blockIdx.x * GQK + c] = ex2(run);
    }
}

__device__ __forceinline__ void ph_prep(Frame& F, const bf16* Q, const bf16* Kk, const float* BC, bf16* QD, bf16* KST, bf16* SM) {
    const int lane = F.lane, r32 = lane & 31, hi = lane >> 5, fr = lane & 15, fq = lane >> 4, lo8 = r32 * 16 + hi * 8;
    const int gw = blockIdx.x * NWAVES + F.wave, NGW = F.G * NWAVES;
    LAS bf16* kl = (LAS bf16*)(F.lds + F.wave * 16384);
    for (int task = gw; task < (M / 64) * GH * 2; task += NGW) {
        const int unit = task >> 1, th = task & 1, cidx = unit >> 2, h = unit & 3, m0 = cidx * 64, cb = h * GDK;
        const int t = 32 * th + r32;
        f32x16 s0 = {}, s1 = {};
        const size_t opt = ((size_t)unit * 2 + th) * 8192 + lo8, op0 = (size_t)unit * 2 * 8192 + lo8, opl = ((size_t)unit * 2 + 1) * 8192 + 31 * 16 + hi * 8;
        bf16* qdo = QD + (size_t)unit * 16384 + (size_t)(t >> 4) * 512 + (r32 & 15) * 8;
#pragma unroll 4
        for (int s = 0; s < 16; ++s) {
            const int d8 = 16 * s + 8 * hi;
            const v4u qv = *(const v4u*)(Q + opt + s * 512), kv = *(const v4u*)(Kk + opt + s * 512);
            const f32x4 b0 = *(const f32x4*)(BC + opt + s * 512), b1 = *(const f32x4*)(BC + opt + s * 512 + 4), l0 = *(const f32x4*)(BC + opl + s * 512), l1 = *(const f32x4*)(BC + opl + s * 512 + 4);
            const float qf[8] = {bf_lo(qv.x), bf_hi(qv.x), bf_lo(qv.y), bf_hi(qv.y), bf_lo(qv.z), bf_hi(qv.z), bf_lo(qv.w), bf_hi(qv.w)};
            const float kf[8] = {bf_lo(kv.x), bf_hi(kv.x), bf_lo(kv.y), bf_hi(kv.y), bf_lo(kv.z), bf_hi(kv.z), bf_lo(kv.w), bf_hi(kv.w)};
            const float bc[8] = {b0[0], b0[1], b0[2], b0[3], b1[0], b1[1], b1[2], b1[3]}, bl[8] = {l0[0], l0[1], l0[2], l0[3], l1[0], l1[1], l1[2], l1[3]};
            float qd[8], ki[8], ks[8];
#pragma unroll
            for (int i = 0; i < 8; ++i) { qd[i] = qf[i] * 0.0625f * ex2(bc[i]); ki[i] = kf[i] * ex2(-bc[i]); ks[i] = kf[i] * ex2(bl[i] - bc[i]); }
            v4u qdp, kip; qdp.x = cvtpk(qd[0], qd[1]); qdp.y = cvtpk(qd[2], qd[3]); qdp.z = cvtpk(qd[4], qd[5]); qdp.w = cvtpk(qd[6], qd[7]);
            kip.x = cvtpk(ki[0], ki[1]); kip.y = cvtpk(ki[2], ki[3]); kip.z = cvtpk(ki[4], ki[5]); kip.w = cvtpk(ki[6], ki[7]);
            *(v4u*)(qdo + (s >> 1) * 2048 + (2 * (s & 1) + hi) * 128) = qdp;
#pragma unroll
            for (int i = 0; i < 8; i += 2) { const unsigned p2 = cvtpk(ks[i], ks[i + 1]); kl[(d8 + i) * 32 + r32] = (bf16)(p2 & 0xffffu); kl[(d8 + i + 1) * 32 + r32] = (bf16)(p2 >> 16); }
            if (th == 0) { s0 = __builtin_amdgcn_mfma_f32_32x32x16_bf16(as_bf16x8(kip), as_bf16x8(qdp), s0, 0, 0, 0); }
            else {
                const v4u k0 = *(const v4u*)(Kk + op0 + s * 512); const f32x4 c0 = *(const f32x4*)(BC + op0 + s * 512), c1 = *(const f32x4*)(BC + op0 + s * 512 + 4);
                v4u k0p; k0p.x = cvtpk(bf_lo(k0.x) * ex2(-c0[0]), bf_hi(k0.x) * ex2(-c0[1])); k0p.y = cvtpk(bf_lo(k0.y) * ex2(-c0[2]), bf_hi(k0.y) * ex2(-c0[3]));
                k0p.z = cvtpk(bf_lo(k0.z) * ex2(-c1[0]), bf_hi(k0.z) * ex2(-c1[1])); k0p.w = cvtpk(bf_lo(k0.w) * ex2(-c1[2]), bf_hi(k0.w) * ex2(-c1[3]));
                s0 = __builtin_amdgcn_mfma_f32_32x32x16_bf16(as_bf16x8(k0p), as_bf16x8(qdp), s0, 0, 0, 0);
                s1 = __builtin_amdgcn_mfma_f32_32x32x16_bf16(as_bf16x8(kip), as_bf16x8(qdp), s1, 0, 0, 0);
            }
        }
        LDS_WAIT(); asm volatile("" ::: "memory");
        { bf16* ko = KST + (size_t)unit * 16384 + th * 512 + lane * 8;
#pragma unroll
            for (int q = 0; q < 16; ++q) { const int w = q >> 1, k2 = q & 1, dk = 32 * w + 8 * (fr >> 2) + 4 * k2 + (fr & 3);
                *(v4u*)(ko + q * 1024) = *(const LAS v4u*)(kl + dk * 32 + 8 * fq); } }
        LDS_WAIT(); asm volatile("" ::: "memory");
        bf16* smo = SM + (size_t)unit * 4096 + (size_t)(t >> 4) * 1024 + (r32 & 15) * 8 + 4 * hi;
#pragma unroll
        for (int g = 0; g < 4; ++g) {
            const int sb = 8 * g + 4 * hi;
            float v0[4], v1[4];
#pragma unroll
            for (int i = 0; i < 4; ++i) { v0[i] = (sb + i <= t) ? s0[4 * g + i] : 0.f; v1[i] = (th == 1 && 32 + sb + i <= t) ? s1[4 * g + i] : 0.f; }
            v2u w0, w1; w0.x = cvtpk(v0[0], v0[1]); w0.y = cvtpk(v0[2], v0[3]); w1.x = cvtpk(v1[0], v1[1]); w1.y = cvtpk(v1[2], v1[3]);
            *(v2u*)(smo + g * 128) = w0; *(v2u*)(smo + 512 + g * 128) = w1;
        }
    }
}

struct ScanRegs { v4u ka[2][2]; v4u vt1; float decw; v4u sm[2]; v2u rr; };
struct ScanQ { v4u qb[4]; };
__device__ __forceinline__ void ph_scan(Frame& F, const bf16* QD, const bf16* KST, const bf16* SM, const bf16* VT, const float* DECAY, const bf16* RF, const float* ng, bf16* O, float* SSQ) {
    const int vb = F.vcu, b = vb / 64, h = (vb / 16) % 4, es = vb % 16, w = F.wave, lane = F.lane, fr = lane & 15, fq = lane >> 4;
    const int e0 = h * GDV + es * 32, ttw = w & 3, gw_ = w >> 2;
    LAS f32x4* red = (LAS f32x4*)F.lds;
    LAS v4u* vtl = (LAS v4u*)(F.lds + 131072);
    f32x4 St[2][2];
#pragma unroll
    for (int g = 0; g < 2; ++g)
#pragma unroll
        for (int k2 = 0; k2 < 2; ++k2) St[g][k2] = (f32x4){0.f, 0.f, 0.f, 0.f};
    const size_t unit0 = (size_t)(b * (T / 64)) * GH + h;
    const bf16* kp0 = KST + (unit0 * 8 + w) * 2048 + lane * 8;
    const bf16* vp0 = VT + (((size_t)(b * (T / 64)) * 128 + (e0 >> 4) + ((w >> 1) & 1)) * 2 + (w & 1)) * 512 + lane * 8;
    const float* dp0 = DECAY + (size_t)(b * (T / 64)) * GQK + h * GDK + 32 * w + (lane & 31);
    const bf16* qp0 = QD + (unit0 * 8 + w) * 2048 + lane * 8;
    const bf16* sp0 = SM + (unit0 * 4 + ttw) * 1024 + lane * 8;
    const bf16* rp0 = RF + (((((size_t)(b * (T / 64)) * 128 + (e0 >> 4) + gw_) * 4 + ttw) * 2 + (fq >> 1)) * 16 + fr) * 8 + (fq & 1) * 4;
    const f32x4 ngv = *(const f32x4*)(ng + es * 32 + 16 * gw_ + 4 * fq);
    auto load = [&](ScanRegs& r, int n) {
#pragma unroll
        for (int k2 = 0; k2 < 2; ++k2)
#pragma unroll
            for (int ks = 0; ks < 2; ++ks) r.ka[k2][ks] = *(const v4u*)(kp0 + (size_t)n * 65536 + (k2 * 2 + ks) * 512);
        if (w < 4) r.vt1 = *(const v4u*)(vp0 + (size_t)n * 131072);
        r.decw = dp0[(size_t)n * GQK];
#pragma unroll
        for (int ks = 0; ks < 2; ++ks) r.sm[ks] = *(const v4u*)(sp0 + (size_t)n * 16384 + ks * 512);
        r.rr = *(const v2u*)(rp0 + (size_t)n * 131072);
    };
    auto loadq = [&](ScanQ& r, int n) {
#pragma unroll
        for (int tt = 0; tt < 4; ++tt) r.qb[tt] = *(const v4u*)(qp0 + (size_t)n * 65536 + tt * 512);
    };
#if SEGPROBE
    unsigned long long sg_acc = 0ull, sg_t = 0ull; const bool sg_on = (blockIdx.x == 8 && w == SEGWAVE);
#define SG_A(n_) if (SEGPROBE == n_ && sg_on) sg_t = __builtin_amdgcn_s_memrealtime();
#define SG_B(n_) if (SEGPROBE == n_ && sg_on) sg_acc += __builtin_amdgcn_s_memrealtime() - sg_t;
#else
#define SG_A(n_)
#define SG_B(n_)
#endif
    auto compute = [&](const ScanRegs& r, const ScanQ& rq, int n) {
        SG_A(11)
        const f32x4 zero = (f32x4){0.f, 0.f, 0.f, 0.f};
        LAS f32x4* rb = red + (n & 1) * 4096; LAS v4u* vb_ = vtl + (n & 1) * 256;
        if (w < 4) vb_[w * 64 + lane] = r.vt1;
#pragma unroll
        for (int g = 0; g < 2; ++g) {
            v4u sa; sa.x = cvtpk(St[g][0][0], St[g][0][1]); sa.y = cvtpk(St[g][0][2], St[g][0][3]); sa.z = cvtpk(St[g][1][0], St[g][1][1]); sa.w = cvtpk(St[g][1][2], St[g][1][3]);
#pragma unroll
            for (int tt = 0; tt < 4; ++tt) rb[(w * 8 + g * 4 + tt) * 64 + lane] = __builtin_amdgcn_mfma_f32_16x16x32_bf16(as_bf16x8(sa), as_bf16x8(rq.qb[tt]), zero, 0, 0, 0);
        }
        asm volatile("s_waitcnt lgkmcnt(0)" ::: "memory"); SG_B(11) SG_A(12) __builtin_amdgcn_s_barrier(); SG_B(12) SG_A(13) asm volatile("" ::: "memory");
        v4u vt[2][2]; f32x4 pt[8];
#pragma unroll
        for (int g = 0; g < 2; ++g)
#pragma unroll
            for (int ks = 0; ks < 2; ++ks) vt[g][ks] = vb_[(g * 2 + ks) * 64 + lane];
#pragma unroll
        for (int ww = 0; ww < 8; ++ww) pt[ww] = rb[(ww * 8 + w) * 64 + lane];
        asm volatile("s_waitcnt lgkmcnt(0)" ::: "memory");
        f32x4 oi = __builtin_amdgcn_mfma_f32_16x16x32_bf16(as_bf16x8(gw_ ? vt[1][0] : vt[0][0]), as_bf16x8(r.sm[0]), zero, 0, 0, 0);
        oi = __builtin_amdgcn_mfma_f32_16x16x32_bf16(as_bf16x8(gw_ ? vt[1][1] : vt[0][1]), as_bf16x8(r.sm[1]), oi, 0, 0, 0);
        oi += ((pt[0] + pt[1]) + (pt[2] + pt[3])) + ((pt[4] + pt[5]) + (pt[6] + pt[7]));
        const int m = (b * (T / 64) + n) * 64 + 16 * ttw + fr;
        { const f32x4 rv = {bf_lo(r.rr.x), bf_hi(r.rr.x), bf_lo(r.rr.y), bf_hi(r.rr.y)}; f32x4 y;
#pragma unroll
          for (int i = 0; i < 4; ++i) y[i] = oi[i] * ngv[i] * (rv[i] * __builtin_amdgcn_rcpf(1.f + ex2(-LOG2E * rv[i])));
          v2u ow; ow.x = cvtpk(y[0], y[1]); ow.y = cvtpk(y[2], y[3]); *(v2u*)(O + (size_t)m * D + e0 + 16 * gw_ + 4 * fq) = ow; }
        float q = (oi[0] * oi[0] + oi[1] * oi[1]) + (oi[2] * oi[2] + oi[3] * oi[3]);
        q += __shfl_xor(q, 16); q += __shfl_xor(q, 32);
        if (fq == 0) SSQ[(size_t)m * 128 + h * 32 + es * 2 + gw_] = q;
        f32x4 dec[2];
#pragma unroll
        for (int k2 = 0; k2 < 2; ++k2)
#pragma unroll
            for (int i = 0; i < 4; ++i) dec[k2][i] = __shfl(r.decw, 8 * fq + 4 * k2 + i);
#pragma unroll
        for (int g = 0; g < 2; ++g)
#pragma unroll
            for (int k2 = 0; k2 < 2; ++k2) { f32x4 s = St[g][k2] * dec[k2];
                s = __builtin_amdgcn_mfma_f32_16x16x32_bf16(as_bf16x8(r.ka[k2][0]), as_bf16x8(vt[g][0]), s, 0, 0, 0);
                s = __builtin_amdgcn_mfma_f32_16x16x32_bf16(as_bf16x8(r.ka[k2][1]), as_bf16x8(vt[g][1]), s, 0, 0, 0); St[g][k2] = s; }
        SG_B(13)
    };
    constexpr int NCH = T / 64;
#define CL(n_) ((n_) < NCH ? (n_) : NCH - 1)
    ScanRegs A, B; ScanQ Q0, Q1, Q2;
    load(A, 0); loadq(Q0, 0); loadq(Q1, 1);
#pragma unroll 1
    for (int n = 0; n < NCH - 4; n += 6) {
        load(B, CL(n + 1)); loadq(Q2, CL(n + 2)); compute(A, Q0, n);
        load(A, CL(n + 2)); loadq(Q0, CL(n + 3)); compute(B, Q1, n + 1);
        load(B, CL(n + 3)); loadq(Q1, CL(n + 4)); compute(A, Q2, n + 2);
        load(A, CL(n + 4)); loadq(Q2, CL(n + 5)); compute(B, Q0, n + 3);
        load(B, CL(n + 5)); loadq(Q0, CL(n + 6)); compute(A, Q1, n + 4);
        load(A, CL(n + 6)); loadq(Q1, CL(n + 7)); compute(B, Q2, n + 5);
    }
    load(B, 61); loadq(Q2, 62); compute(A, Q0, 60);
    load(A, 62); loadq(Q0, 63); compute(B, Q1, 61);
    load(B, 63); compute(A, Q2, 62);
    compute(B, Q0, 63);
#undef CL
    asm volatile("s_waitcnt vmcnt(0) lgkmcnt(0)" ::: "memory"); __builtin_amdgcn_s_barrier(); asm volatile("" ::: "memory");
#if SEGPROBE
    if (sg_on && lane == 0) *(LAS unsigned long long*)(F.lds + LDSCTL_OFF + 480) += sg_acc;
#endif
}

__device__ __forceinline__ void ph_rs(Frame& F, const float* SSQ, float* RS) {
    const int t = F.tid, m = blockIdx.x * 64 + (t >> 3), j = t & 7;
    const f32x4* p = (const f32x4*)(SSQ + (size_t)m * 128 + j * 16);
    const f32x4 a = p[0], b4 = p[1], c = p[2], d = p[3];
    const f32x4 s4 = (a + b4) + (c + d);
    float q = (s4[0] + s4[1]) + (s4[2] + s4[3]);
    q += __shfl_xor(q, 1);
    const float rs = 1.f / sqrtf(q * (1.f / GDV) + RMS_EPS);
    const int base = F.lane & ~7;
    const float r0 = __shfl(rs, base), r1 = __shfl(rs, base + 2), r2 = __shfl(rs, base + 4), r3 = __shfl(rs, base + 6);
    if (j == 0) *(f32x4*)(RS + (size_t)m * 4) = (f32x4){r0 / r1, r1 / r2, r2 / r3, r3};
}

__device__ __forceinline__ void sb_block_direct(const bf16* QF, const bf16* KF, const bf16* VF, bf16* OG, int bh, int qb, int lane) {
    const int r32 = lane & 31, hi = lane >> 5;
    const int lo8 = r32 * 16 + hi * 8;
    {
        const int h = bh % SH, b = bh / SH;
        const size_t mb = (size_t)b * T; const int t = 32 * qb + r32;
        const bf16* qp = QF + ((size_t)bh * (T / 32) + qb) * 4096 + lo8;
        bf16x8 qf[8];
#pragma unroll
        for (int s = 0; s < 8; ++s) qf[s] = as_bf16x8(*(const v4u*)(qp + s * 512));
        f32x16 o[4];
#pragma unroll
        for (int dt = 0; dt < 4; ++dt) o[dt] = f32x16{};
        float cprod = 1.f;
        const bf16* kp = KF + ((size_t)bh * (T / 32) + qb) * 4096 + lo8;
        const bf16* vp = VF + ((size_t)bh * (T / 32) + qb) * 4096 + lo8;
        v4u kf[8];
#pragma unroll
        for (int s = 0; s < 8; ++s) kf[s] = *(const v4u*)(kp + s * 512);
#pragma unroll 1
        for (int jt = qb; jt >= 0; --jt) {
            v4u vf[4][2];
#pragma unroll
            for (int dt = 0; dt < 4; ++dt)
#pragma unroll
                for (int ks = 0; ks < 2; ++ks) vf[dt][ks] = *(const v4u*)(vp + (dt * 2 + ks) * 512);
            f32x16 z = f32x16{};
#pragma unroll
            for (int s = 0; s < 8; ++s) z = __builtin_amdgcn_mfma_f32_32x32x16_bf16(as_bf16x8(kf[s]), qf[s], z, 0, 0, 0);
            kp -= (jt > 0) ? 4096 : 0; vp -= 4096;
#pragma unroll
            for (int s = 0; s < 8; ++s) kf[s] = *(const v4u*)(kp + s * 512);
            typedef float f32x2v __attribute__((ext_vector_type(2)));
            f32x2v bt[8], om[8];
#pragma unroll
            for (int p = 0; p < 8; ++p) {
                const f32x2v zc = {fmaxf(z[2 * p], -126.f), fmaxf(z[2 * p + 1], -126.f)};
                const f32x2v e = {ex2(-zc.x), ex2(-zc.y)}; const f32x2v d = e + 1.0f;
                const f32x2v rc = {__builtin_amdgcn_rcpf(d.x), __builtin_amdgcn_rcpf(d.y)};
                bt[p] = rc; om[p] = e * rc;
            }
            if (jt == qb) {
#pragma unroll
                for (int p = 0; p < 8; ++p) { if (16 * hi + 2 * p >= r32) { bt[p].x = 0.f; om[p].x = 1.f; } if (16 * hi + 2 * p + 1 >= r32) { bt[p].y = 0.f; om[p].y = 1.f; } }
            }
            float wv[16]; float run = 1.f;
#pragma unroll
            for (int p = 7; p >= 0; --p) { wv[2 * p + 1] = bt[p].y * run; run *= om[p].y; wv[2 * p] = bt[p].x * run; run *= om[p].x; }
            const float other = __shfl_xor(run, 32);
            const float fac = cprod * (hi == 0 ? other : 1.f);
            cprod *= run * other;
            v4u pb[2];
            { f32x2v wf[8];
#pragma unroll
                for (int p = 0; p < 8; ++p) { const f32x2v w2 = {wv[2 * p], wv[2 * p + 1]}; wf[p] = w2 * fac; }
#pragma unroll
                for (int ks = 0; ks < 2; ++ks) { pb[ks].x = cvtpk(wf[4 * ks].x, wf[4 * ks].y); pb[ks].y = cvtpk(wf[4 * ks + 1].x, wf[4 * ks + 1].y);
                    pb[ks].z = cvtpk(wf[4 * ks + 2].x, wf[4 * ks + 2].y); pb[ks].w = cvtpk(wf[4 * ks + 3].x, wf[4 * ks + 3].y); } }
#pragma unroll
            for (int dt = 0; dt < 4; ++dt)
#pragma unroll
                for (int ks = 0; ks < 2; ++ks) o[dt] = __builtin_amdgcn_mfma_f32_32x32x16_bf16(as_bf16x8(vf[dt][ks]), as_bf16x8(pb[ks]), o[dt], 0, 0, 0);
            if (__builtin_amdgcn_ballot_w64(cprod >= 0x1p-134f) == 0ull) break;
        }
        bf16* orow = OG + (mb + t) * D + h * SHD;
#pragma unroll
        for (int dt = 0; dt < 4; ++dt)
#pragma unroll
            for (int g = 0; g < 4; ++g) { v2u w; w.x = cvtpk(o[dt][4 * g], o[dt][4 * g + 1]); w.y = cvtpk(o[dt][4 * g + 2], o[dt][4 * g + 3]); *(v2u*)(orow + 32 * dt + 8 * g + 4 * hi) = w; }
    }
}

__device__ __forceinline__ void ph_sb(Frame& F, const bf16* QF, const bf16* KF, const bf16* VF, bf16* OG) {
    const int lane = F.lane, r32 = lane & 31, hi = lane >> 5;
    const int wu = __builtin_amdgcn_readfirstlane(F.wave);
    const int lo8 = r32 * 16 + hi * 8;
    constexpr int RING = 9, LEAD = 7, NSTRIP = (T / 32) / 32;
#if SEGPROBE
    unsigned long long seg_acc = 0ull, seg_t = 0ull; const bool seg_on = (blockIdx.x == 8 && wu == 0);
#define SEG_A(n_) if (SEGPROBE == n_ && seg_on) seg_t = __builtin_amdgcn_s_memrealtime();
#define SEG_B(n_) if (SEGPROBE == n_ && seg_on) seg_acc += __builtin_amdgcn_s_memrealtime() - seg_t;
#else
#define SEG_A(n_)
#define SEG_B(n_)
#endif
    LAS unsigned char* ring = F.lds;
    volatile LAS unsigned* flg = (volatile LAS unsigned*)(F.lds + RING * 16384);
    const unsigned dsrc = (unsigned)(lo8 * 2);
#pragma unroll 1
    for (int strip = F.vcu; strip < NB * SH * NSTRIP; strip += F.G) {
        const int bh = strip / NSTRIP, part = strip % NSTRIP, h = bh % SH, b = bh / SH, top = 32 * part + 31;
        const size_t mb = (size_t)b * T;
        const unsigned char* kbase = (const unsigned char*)(KF + (size_t)bh * (T / 32) * 4096) + wu * 1024 + dsrc;
        const unsigned char* vbase = (const unsigned char*)(VF + (size_t)bh * (T / 32) * 4096) + wu * 1024 + dsrc;
        auto dma_tile = [&](int tj) {
            const unsigned la = (unsigned)(size_t)(ring + (tj % RING) * 16384 + wu * 1024), lb = la + 8192u;
            const unsigned char* gk = kbase + (size_t)tj * 8192; const unsigned char* gv = vbase + (size_t)tj * 8192;
            asm volatile("s_mov_b32 m0, %0\n\ts_nop 0\n\tglobal_load_lds_dwordx4 %2, off\n\ts_mov_b32 m0, %1\n\ts_nop 0\n\tglobal_load_lds_dwordx4 %3, off" :: "s"(la), "s"(lb), "v"(gk), "v"(gv) : "memory", "m0");
        };
        bf16x8 qf[8], qn[8];
        auto load_q = [&](bf16x8 (&dst)[8], int qb_) { const bf16* qp = QF + ((size_t)bh * (T / 32) + qb_) * 4096 + lo8;
#pragma unroll
            for (int s = 0; s < 8; ++s) dst[s] = as_bf16x8(*(const v4u*)(qp + s * 512)); };
        int k = 0, qb = top - wu;
        bool walking = false; unsigned deferred = 0u;
        int age = 1000; bool fin_q = false;
        int age2 = 1000;
        load_q(qf, qb); load_q(qn, qb - 8);
#pragma unroll 1
        for (int j = 0; j < LEAD; ++j) dma_tile(top - j);
        asm volatile("" ::: "memory"); __builtin_amdgcn_s_waitcnt(0x0070); asm volatile("" ::: "memory");
        f32x16 o[4];
#pragma unroll
        for (int dt = 0; dt < 4; ++dt) o[dt] = f32x16{};
        float cprod = 1.f;
        bool pend = false; int qdone = 0, kdone = 0;
        auto finish_block = [&]() {
            SEG_A(4)
            age2 = age; age = 0; fin_q = false;
            if (k < 4) {
                if (k == kdone + 1) {
#pragma unroll
                    for (int s = 0; s < 8; ++s) qf[s] = qn[s];
                } else { load_q(qf, qb); fin_q = true; age2 = 0; }
                if (k < 3) { load_q(qn, qb - 8); fin_q = true; }
            }
            asm volatile("" ::: "memory");
            bf16* orow = OG + (mb + 32 * qdone + r32) * D + h * SHD;
#pragma unroll
            for (int dt = 0; dt < 4; ++dt)
#pragma unroll
                for (int g = 0; g < 4; ++g) { v2u w; w.x = cvtpk(o[dt][4 * g], o[dt][4 * g + 1]); w.y = cvtpk(o[dt][4 * g + 2], o[dt][4 * g + 3]); *(v2u*)(orow + 32 * dt + 8 * g + 4 * hi) = w; }
#pragma unroll
            for (int dt = 0; dt < 4; ++dt) o[dt] = f32x16{};
            cprod = 1.f; pend = false;
            SEG_B(4)
        };
#pragma unroll 1
        for (int tj = top; tj >= 0; --tj) {
            if (lane == 0) flg[(tj & 1) * 8 + wu] = (k < 4) ? 1u : 0u;
            SEG_A(1)
            asm volatile("" ::: "memory");
            ++age; ++age2;
            static_assert(LEAD == 7, "wait-count encodings below are for LEAD = 7");
            if (tj < LEAD - 1) __builtin_amdgcn_s_waitcnt(0x0070);
            else if (age <= LEAD && age2 > LEAD) { if (fin_q) __builtin_amdgcn_s_waitcnt(0x8074);
                                                   else __builtin_amdgcn_s_waitcnt(0x407C); }
            else __builtin_amdgcn_s_waitcnt(0x007C);
            asm volatile("" ::: "memory");
            SEG_B(1) SEG_A(2)
            __builtin_amdgcn_s_barrier(); asm volatile("" ::: "memory");
            { const v4u f0 = *(const LAS v4u*)(ring + RING * 16384 + (tj & 1) * 32), f1 = *(const LAS v4u*)(ring + RING * 16384 + (tj & 1) * 32 + 16);
              const unsigned any = (f0.x | f0.y) | (f0.z | f0.w) | (f1.x | f1.y) | (f1.z | f1.w);
              if (__builtin_amdgcn_readfirstlane(any) == 0u) break; }
            SEG_B(2)
            if (tj - LEAD >= 0) dma_tile(tj - LEAD);
            if (pend) finish_block();
            if (k < 4 && tj == qb) walking = true;
            SEG_A(3)
            if (walking) {
                SEG_A(5)
                const LAS unsigned char* sl = ring + (tj % RING) * 16384 + lane * 16;
                v4u kf[8];
#pragma unroll
                for (int s = 0; s < 8; ++s) kf[s] = *(const LAS v4u*)(sl + s * 1024);
                f32x16 z = f32x16{};
#pragma unroll
                for (int s = 0; s < 8; ++s) z = __builtin_amdgcn_mfma_f32_32x32x16_bf16(as_bf16x8(kf[s]), qf[s], z, 0, 0, 0);
                v4u vf[4][2];
#pragma unroll
                for (int dt = 0; dt < 4; ++dt)
#pragma unroll
                    for (int ks = 0; ks < 2; ++ks) vf[dt][ks] = *(const LAS v4u*)(sl + 8192 + (dt * 2 + ks) * 1024);
                typedef float f32x2v __attribute__((ext_vector_type(2)));
                f32x2v bt[8], om[8];
#pragma unroll
                for (int p = 0; p < 8; ++p) {
                    const f32x2v zc = {fmaxf(z[2 * p], -126.f), fmaxf(z[2 * p + 1], -126.f)};
                    const f32x2v e = {ex2(-zc.x), ex2(-zc.y)}; const f32x2v d = e + 1.0f;
                    const f32x2v rc = {__builtin_amdgcn_rcpf(d.x), __builtin_amdgcn_rcpf(d.y)};
                    bt[p] = rc; om[p] = e * rc;
                }
                if (tj == qb) {
#pragma unroll
                    for (int p = 0; p < 8; ++p) { if (16 * hi + 2 * p >= r32) { bt[p].x = 0.f; om[p].x = 1.f; } if (16 * hi + 2 * p + 1 >= r32) { bt[p].y = 0.f; om[p].y = 1.f; } }
                }
                float wv[16]; float run = 1.f;
#pragma unroll
                for (int p = 7; p >= 0; --p) { wv[2 * p + 1] = bt[p].y * run; run *= om[p].y; wv[2 * p] = bt[p].x * run; run *= om[p].x; }
                const float other = __shfl_xor(run, 32);
                const float fac = cprod * (hi == 0 ? other : 1.f);
                cprod *= run * other;
                v4u pb[2];
                { f32x2v wf[8];
#pragma unroll
                    for (int p = 0; p < 8; ++p) { const f32x2v w2 = {wv[2 * p], wv[2 * p + 1]}; wf[p] = w2 * fac; }
#pragma unroll
                    for (int ks = 0; ks < 2; ++ks) { pb[ks].x = cvtpk(wf[4 * ks].x, wf[4 * ks].y); pb[ks].y = cvtpk(wf[4 * ks + 1].x, wf[4 * ks + 1].y);
                        pb[ks].z = cvtpk(wf[4 * ks + 2].x, wf[4 * ks + 2].y); pb[ks].w = cvtpk(wf[4 * ks + 3].x, wf[4 * ks + 3].y); } }
#pragma unroll
                for (int dt = 0; dt < 4; ++dt)
#pragma unroll
                    for (int ks = 0; ks < 2; ++ks) o[dt] = __builtin_amdgcn_mfma_f32_32x32x16_bf16(as_bf16x8(vf[dt][ks]), as_bf16x8(pb[ks]), o[dt], 0, 0, 0);
                SEG_B(5)
                if (tj == 0 || __builtin_amdgcn_ballot_w64(cprod >= 0x1p-134f) == 0ull) {
                    qdone = qb; kdone = k; pend = true;
                    walking = false; ++k; qb -= 8;
                    while (k < 4 && qb >= tj) { deferred |= 1u << k; ++k; qb -= 8; }
                }
            }
            SEG_B(3)
        }
        if (pend) finish_block();
        asm volatile("s_waitcnt vmcnt(0) lgkmcnt(0)" ::: "memory"); __builtin_amdgcn_s_barrier(); asm volatile("" ::: "memory");
#pragma unroll 1
        for (int kk = 1; kk < 4; ++kk) if ((deferred >> kk) & 1u) sb_block_direct(QF, KF, VF, OG, bh, top - wu - 8 * kk, lane);
    }
#if SEGPROBE
    if (seg_on && lane == 0) *(LAS unsigned long long*)(F.lds + LDSCTL_OFF + 480) += seg_acc;
#endif
}

#ifndef TPROBE_MASK
#define TPROBE_MASK 0ull
#endif
#ifndef TPROBE_MUL
#define TPROBE_MUL 4
#endif
constexpr int N_TAIL = 5;
constexpr int N_PHASES = 2 + NA * (4 + N_TAIL) + (DEPTH - NA) * (2 + N_TAIL);
__global__ void __launch_bounds__(NTHREADS, 2) yoco_fwd(Args args) {
    extern __shared__ __attribute__((aligned(16))) unsigned char lds[];
    Frame F;
    F.lds = (LAS unsigned char*)lds;
    F.MISC = (volatile LAS unsigned*)(F.lds + MISC_OFF);
    F.tid = threadIdx.x; F.lane = F.tid & 63; F.wave = __builtin_amdgcn_readfirstlane(F.tid >> 6);
    F.G = gridDim.x; { const int bx = blockIdx.x; F.vcu = (F.G % 8 == 0) ? (bx % 8) * (F.G / 8) + bx / 8 : bx; }
    F.ws = args.ws; F.ctl = (gu32*)(args.ws + WS_CTL);
    for (int u = F.tid; u < (LDS_BYTES - LDSCTL_OFF) / 4; u += NTHREADS) ((LAS unsigned*)(F.lds + LDSCTL_OFF))[u] = 0u;
    __syncthreads();
    const int lo = args.ph_lo, hi = args.ph_hi;
    XcdBarrier bar; bar.bar = (unsigned*)(F.ctl + CW_BAR) + args.li * XCD_BAR_WORDS; bar.x = 0; bar.st = nullptr;
    if (hi - lo > 1) bar = xcd_barrier_post((unsigned*)(F.ctl + CW_BAR) + args.li * XCD_BAR_WORDS, F.MISC + 8);
    int pc = 0;
#if TPROBE_MASK
    unsigned long long tp_acc = 0ull, tp_t0 = 0ull;
#define TP_START if ((TPROBE_MASK >> pc) & 1u) tp_t0 = __builtin_amdgcn_s_memrealtime();
#define TP_STOP  if ((TPROBE_MASK >> pc) & 1u) tp_acc += __builtin_amdgcn_s_memrealtime() - tp_t0;
#else
#define TP_START
#define TP_STOP
#endif
#define PHASE_BEGIN if (pc >= lo && pc < hi) { TP_START { int t_ = threadIdx.x; asm volatile("" : "+v"(t_)); F.tid = t_; F.lane = t_ & 63; }
#define PHASE_END   if (pc + 1 < hi) xcd_barrier(bar); TP_STOP } ++pc;

    unsigned char* ws = args.ws;
    bf16* XA = (bf16*)(ws + WS_XA); bf16* OB = (bf16*)(ws + WS_TB);
    bf16* HA = (bf16*)(ws + WS_HA); bf16* OG = (bf16*)(ws + WS_OG); bf16* U = (bf16*)(ws + WS_U);
    unsigned char* mix = ws + WS_MIX;

    PHASE_BEGIN ph_pro0(F, args); PHASE_END
    PHASE_BEGIN ph_pro1(F, args); PHASE_END

    for (int l = 0; l < DEPTH; ++l) {
        const bf16* wout_t;
        if (l < NA) {
            bf16* win_t = (bf16*)(ws + WS_WIN + (size_t)l * WIN_STRIDE);
            bf16* Q = (bf16*)(mix + MX_Q); bf16* Kk = (bf16*)(mix + MX_K); bf16* R = (bf16*)(mix + MX_R); bf16* VT = (bf16*)(mix + MX_VT);
            float* SSQ = (float*)(ws + WS_SSQ);
            PHASE_BEGIN
                { pg8::EpiBf16Seg E{Q, Kk, R, GQK, GQK, GVD, 4, 8, 1.0f, 7}; run_gemm(F, HA, win_t, M, 4096, D, E); }
                { pg8::EpiBf16Frag E{VT, 3, 1.0f}; run_gemm(F, win_t + (size_t)4096 * D, HA, GVD, M, D, E); }
                ph_gate(F, args, l, HA, win_t + (size_t)6144 * D, (float*)(mix + MX_BC), (float*)(ws + WS_DECAY));
            PHASE_END
            PHASE_BEGIN ph_prep(F, Q, Kk, (const float*)(mix + MX_BC), (bf16*)(mix + MX_QD), (bf16*)(mix + MX_KST), (bf16*)(mix + MX_SM)); PHASE_END
            PHASE_BEGIN ph_scan(F, (const bf16*)(mix + MX_QD), (const bf16*)(mix + MX_KST), (const bf16*)(mix + MX_SM), VT, (const float*)(ws + WS_DECAY), R, args.in[IN_GNG] + l * GDV, OG, SSQ); PHASE_END
            PHASE_BEGIN ph_rs(F, SSQ, (float*)(ws + WS_RS)); PHASE_END
            wout_t = (const bf16*)(ws + WS_WGOUT) + (size_t)l * D * D;
        } else {
            const int j = l - NA;
            bf16* SQ = (bf16*)(mix + MX_SQ); bf16* SK = (bf16*)(mix + MX_SK); bf16* SVT = (bf16*)(mix + MX_SVT); bf16* HKV = (bf16*)(mix + MX_HKV);
            PHASE_BEGIN {
                const int ncall = (j == 0) ? 3 : 1;
                for (int c = 0; c < ncall; ++c) {
                    const bf16* A_ = (c == 0) ? HA : (c == 1) ? HKV : (const bf16*)(ws + WS_WKV) + (size_t)D * D;
                    const bf16* B_ = (c == 0) ? (const bf16*)(ws + WS_WQ) + (size_t)j * D * D : (c == 1) ? (const bf16*)(ws + WS_WKV) : HKV;
                    bf16* O_ = (c == 0) ? SQ : (c == 1) ? SK : SVT;
                    const int M_ = (c == 2) ? D : M, N_ = (c == 2) ? M : D;
                    pg8::EpiBf16Frag E{O_, c, (c == 0) ? LOG2E * 0.08838834764831845f : 1.0f}; run_gemm(F, A_, B_, M_, N_, D, E);
                } }
            PHASE_END
            PHASE_BEGIN ph_sb(F, SQ, SK, SVT, OG); PHASE_END
            wout_t = (const bf16*)(ws + WS_WSOUT) + (size_t)j * D * D;
        }
        PHASE_BEGIN { pg8::EpiResidT E{XA, (bf16*)(ws + WS_TB + 64 * MiB), D, mod_vec(F, l, 0, 2), NMOD, T, ALPHA, l < NA ? 1 : 0, (const float*)(ws + WS_RS), (LAS float*)(F.lds + 131072)}; run_gemm(F, OG, wout_t, M, D, D, E); } PHASE_END
        PHASE_BEGIN ph_ln(F, (const bf16*)(ws + WS_TB + 64 * MiB), (float*)(ws + WS_LNST), HA, args.in[IN_LNG] + (size_t)(l * 2 + 0) * D, args.in[IN_LNB] + (size_t)(l * 2 + 0) * D, mod_vec(F, l, 0, 4), mod_vec(F, l, 0, 3), NMOD); PHASE_END
        PHASE_BEGIN {
            LAS float* lb = (LAS float*)(F.lds + RING_BYTES);
            { pg8::StaticOrder S; S.init(M, FF, F.G, (int)blockIdx.x); pg8::Unit u; const bool has = S.next(F.wave, u); const int pn = __builtin_amdgcn_readfirstlane(has ? u.pn : 0);
              *(LAS f32x4*)(lb + F.wave * 256 + 4 * F.lane) = *(const f32x4*)(args.in[IN_B1] + (size_t)l * FF + pn * 256 + 4 * F.lane); }
            __syncthreads();
            pg8::EpiSqRelu E{U, FF, lb}; run_gemm(F, HA, (const bf16*)(ws + WS_W1) + (size_t)l * D * FF, M, FF, D, E); } PHASE_END
        PHASE_BEGIN {
            const bool last = (l == DEPTH - 1); const int ln = last ? l : l + 1;
            const float* kvm = (const float*)(ws + WS_MOD) + (size_t)DEPTH * NB * NMOD;
            bf16* T2 = (bf16*)(ws + WS_TB);
            { pg8::EpiResidT2 E{(const bf16*)(ws + WS_TB + 64 * MiB), (const float*)(ws + WS_LNST), args.in[IN_LNG] + (size_t)(l * 2 + 0) * D, args.in[IN_LNB] + (size_t)(l * 2 + 0) * D, T2, D,
                                args.in[IN_B2] + (size_t)l * D, mod_vec(F, l, 0, 5), NMOD, T, ALPHA};
              run_gemm(F, U, (const bf16*)(ws + WS_W2) + (size_t)l * D * FF, M, D, FF, E); }
        } PHASE_END
        PHASE_BEGIN {
            const bool last = (l == DEPTH - 1); const int ln = last ? l : l + 1;
            const float* kvm = (const float*)(ws + WS_MOD) + (size_t)DEPTH * NB * NMOD;
            ph_ln2(F, (const bf16*)(ws + WS_TB), last ? nullptr : XA, last ? args.out : nullptr, last ? nullptr : HA, (l == NA - 1) ? (bf16*)(mix + MX_HKV) : nullptr,
                   args.in[IN_LNG] + (size_t)(l * 2 + 1) * D, args.in[IN_LNB] + (size_t)(l * 2 + 1) * D, mod_vec(F, ln, 0, 1), mod_vec(F, ln, 0, 0), NMOD, kvm + D, kvm, 2 * D);
        } PHASE_END
    }
#if TPROBE_MASK
    if (blockIdx.x == 0) { const unsigned long long t0 = __builtin_amdgcn_s_memrealtime(), want = (unsigned long long)TPROBE_MUL * tp_acc;
        while (__builtin_amdgcn_s_memrealtime() - t0 < want) __builtin_amdgcn_s_sleep(8); }
#endif
#if SEGPROBE
    if (blockIdx.x == 8 && threadIdx.x == 0) { const unsigned long long t0 = __builtin_amdgcn_s_memrealtime(), want = (unsigned long long)SEGPROBE_MUL * *(LAS unsigned long long*)(F.lds + LDSCTL_OFF + 480);
        while (__builtin_amdgcn_s_memrealtime() - t0 < want) __builtin_amdgcn_s_sleep(8); }
#endif
#undef PHASE_BEGIN
#undef PHASE_END
}

extern "C" void kernel_launch(void* const* d_in, const int* in_sizes, int n_in, void* d_out, int out_size, void* d_ws, size_t ws_size, hipStream_t stream) {
    static int grid = 0;
    if (grid == 0) {
        if (n_in != 20 || in_sizes[0] != M * D || out_size != M * D || ws_size < WS_END) { fprintf(stderr, "kernel_launch: shape/workspace mismatch: n_in %d in0 %d out %d ws %zu (need %zu)\n", n_in, n_in > 0 ? in_sizes[0] : -1, out_size, ws_size, (size_t)WS_END); grid = -1; return; }
        int dev = 0, cus = 0, per_cu = 0;
        if (hipGetDevice(&dev) != hipSuccess || hipDeviceGetAttribute(&cus, hipDeviceAttributeMultiprocessorCount, dev) != hipSuccess) { grid = -1; return; }
        if (hipFuncSetAttribute((const void*)yoco_fwd, hipFuncAttributeMaxDynamicSharedMemorySize, LDS_BYTES) != hipSuccess) { fprintf(stderr, "kernel_launch: hipFuncSetAttribute failed\n"); grid = -1; return; }
        if (hipOccupancyMaxActiveBlocksPerMultiprocessor(&per_cu, (const void*)yoco_fwd, NTHREADS, LDS_BYTES) != hipSuccess || per_cu < 1) fprintf(stderr, "kernel_launch: occupancy query reports %d\n", per_cu);
        (void)hipGetLastError();
        grid = cus;
        if (grid != 256) fprintf(stderr, "kernel_launch: %d CUs (built for 256)\n", grid);
    }
    if (grid < 0) return;
    if (hipMemsetAsync((char*)d_ws + WS_CTL, 0, CTL_ZERO_BYTES, stream) != hipSuccess) return;
    Args a{};
    for (int i = 0; i < 20; ++i) a.in[i] = (const float*)d_in[i];
    a.out = (float*)d_out; a.ws = (unsigned char*)d_ws;
#if MK_SPLIT
    for (int p = 0; p < N_PHASES; ++p) { a.ph_lo = p; a.ph_hi = p + 1; a.li = 0; hipLaunchKernelGGL(yoco_fwd, dim3(grid), dim3(NTHREADS), LDS_BYTES, stream, a); }
#else
    a.ph_lo = 0; a.ph_hi = N_PHASES; a.li = 0;
    hipLaunchKernelGGL(yoco_fwd, dim3(grid), dim3(NTHREADS), LDS_BYTES, stream, a);
#endif
    const hipError_t le = hipPeekAtLastError();
    if (le != hipSuccess) fprintf(stderr, "kernel_launch: launch failed: %s\n", hipGetErrorName(le));
}
```
